# Optimizing an MI355X kernel written in HIP

```python
import math
import jax, jax.numpy as jnp
from jax import lax
import numpy as np

D_MODEL = 1024
BATCH = 2
SEQ = 8192
DEPTH = 4

D_A = D_MODEL // 2
HEAD_A = 64
N_HEADS_A = D_A // HEAD_A
LORA_DECAY = 64
LORA_ICLR = 64
LORA_GATE = 128
N_DIR = 2
C_RWKV = 3 * D_A + N_DIR * LORA_DECAY + N_DIR * LORA_ICLR + LORA_GATE
RWKV_SPLITS = [D_A, 2 * D_A, 3 * D_A, 3 * D_A + N_DIR * LORA_DECAY,
               3 * D_A + N_DIR * LORA_DECAY + N_DIR * LORA_ICLR]
DECAY_SCALE = math.exp(-0.5)
GN_EPS = 64e-5
HEAD_B = 64
D_B = D_MODEL // 2
N_HEADS_B = D_B // (2 * HEAD_B)
C_ATTN = 3 * D_B
ALIBI_MAX_EXP = 8.0
Q_BLOCK = 128
N_BRANCH = 2
C_IN = C_RWKV + C_ATTN + N_BRANCH * D_MODEL
D_FF = ((8 * D_MODEL // 3 + 127) // 128) * 128
NORM_EPS = 1e-6

kernel_name = 'hybrid_rwkv7_diffattn_macaron_encoder'


def rms_norm(x, g, eps=NORM_EPS):
    xf = x.astype(jnp.float32)
    y = xf * lax.rsqrt(jnp.mean(xf * xf, axis=-1, keepdims=True) + eps)
    return (y * g.astype(jnp.float32)).astype(x.dtype)


def swiglu(h, w_in, w_out):
    gate, up = jnp.split(h @ w_in, 2, axis=-1)
    return (jax.nn.silu(gate) * up) @ w_out


def centred_shift(p):
    prev = jnp.pad(p[:, :-1], ((0, 0), (1, 0), (0, 0)))
    nxt = jnp.pad(p[:, 1:], ((0, 0), (0, 1), (0, 0)))
    return 0.5 * (prev + nxt)


def to_heads(t, n_heads):
    return t.reshape(t.shape[:-1] + (n_heads, t.shape[-1] // n_heads))


def rwkv7_scan(r, w, k, v, kk, a, reverse):
    b, s, h, n = r.shape
    xs = tuple(jnp.moveaxis(t.astype(jnp.float32), 1, 0) for t in (r, w, k, v, kk, a))

    def step(state, inp):
        r_t, w_t, k_t, v_t, kk_t, a_t = inp
        sa = jnp.einsum('bhvk,bhk->bhv', state, -kk_t)
        state = (state * w_t[:, :, None, :]
                 + sa[..., None] * (kk_t * a_t)[:, :, None, :]
                 + v_t[..., None] * k_t[:, :, None, :])
        y_t = jnp.einsum('bhvk,bhk->bhv', state, r_t)
        return state, y_t

    s0 = jnp.zeros((b, h, n, n), jnp.float32)
    _, ys = lax.scan(step, s0, xs, reverse=reverse)
    return jnp.moveaxis(ys, 0, 1)


def rwkv7_mixer(p, mu, w0, w2, a0, a2, g2, k_k, k_a, r_k, ln_g, ln_b):
    p = p + mu * (centred_shift(p) - p)
    r, k, v, dw, da, dg = jnp.split(p, RWKV_SPLITS, axis=-1)
    b, s, _ = r.shape
    dw = dw.reshape(b, s, N_DIR, LORA_DECAY)
    da = da.reshape(b, s, N_DIR, LORA_ICLR)
    decay = jnp.exp(-DECAY_SCALE * jax.nn.sigmoid(
        w0 + jnp.einsum('bsgr,grc->bsgc', jnp.tanh(dw), w2)))
    iclr = jax.nn.sigmoid(a0 + jnp.einsum('bsgr,grc->bsgc', da, a2))
    gate = jax.nn.sigmoid(dg) @ g2
    kk = to_heads(k * k_k, N_HEADS_A).astype(jnp.float32)
    kk = kk / jnp.maximum(jnp.sqrt(jnp.sum(kk * kk, axis=-1, keepdims=True)), 1e-12)
    k_dir = k[:, :, None, :] * (1.0 + (iclr - 1.0) * k_a)
    r_h = to_heads(r, N_HEADS_A)
    v_h = to_heads(v, N_HEADS_A)
    k_h = to_heads(k_dir, N_HEADS_A)
    w_h = to_heads(decay, N_HEADS_A)
    a_h = to_heads(iclr, N_HEADS_A)
    y = (rwkv7_scan(r_h, w_h[:, :, 0], k_h[:, :, 0], v_h, kk, a_h[:, :, 0], False)
         + rwkv7_scan(r_h, w_h[:, :, 1], k_h[:, :, 1], v_h, kk, a_h[:, :, 1], True))
    mean = jnp.mean(y, axis=-1, keepdims=True)
    var = jnp.mean(jnp.square(y - mean), axis=-1, keepdims=True)
    y = ((y - mean) * lax.rsqrt(var + GN_EPS)).reshape(b, s, D_A) * ln_g + ln_b
    bonus = jnp.einsum('bshn,bsghn,hn->bsh', r_h.astype(jnp.float32),
                       k_h.astype(jnp.float32), r_k.astype(jnp.float32))[..., None] * v_h
    return (y + bonus.reshape(b, s, D_A)) * gate


def diff_attention(p, q_gain, k_gain, lam_vecs, sub_g, lam_init):
    b, s, _ = p.shape
    q, k, v = jnp.split(p, 3, axis=-1)
    q = rms_norm(q.reshape(b, s, N_HEADS_B, 2, HEAD_B), q_gain)
    k = rms_norm(k.reshape(b, s, N_HEADS_B, 2, HEAD_B), k_gain)
    v = v.reshape(b, s, N_HEADS_B, 2 * HEAD_B)
    lv = lam_vecs.astype(jnp.float32)
    lam = jnp.exp(jnp.sum(lv[0] * lv[1])) - jnp.exp(jnp.sum(lv[2] * lv[3])) + lam_init
    n_blk = s // Q_BLOCK
    q_blk = q.reshape(b, n_blk, Q_BLOCK, N_HEADS_B, 2, HEAD_B).transpose(1, 0, 3, 4, 2, 5)
    k_t = k.transpose(0, 2, 3, 1, 4)
    v_t = v.transpose(0, 2, 1, 3)
    slopes = 2.0 ** (-ALIBI_MAX_EXP * jnp.arange(1, N_HEADS_B + 1, dtype=jnp.float32) / N_HEADS_B)
    k_pos = jnp.arange(s, dtype=jnp.float32)
    q_pos = k_pos.reshape(n_blk, Q_BLOCK)
    scale = HEAD_B ** -0.5

    def attend_block(args):
        qb, qp = args
        logits = jnp.einsum('bhmqd,bhmkd->bhmqk', qb, k_t,
                            preferred_element_type=jnp.float32) * scale
        bias = -slopes[:, None, None] * jnp.abs(qp[:, None] - k_pos[None, :])
        prob = jax.nn.softmax(logits + bias[None, :, None], axis=-1)
        attn = prob[:, :, 0] - lam * prob[:, :, 1]
        return jnp.einsum('bhqk,bhkc->bhqc', attn.astype(v_t.dtype), v_t)

    o = lax.map(attend_block, (q_blk, q_pos))
    o = o.transpose(1, 0, 3, 2, 4).reshape(b, s, N_HEADS_B, 2 * HEAD_B)
    o = rms_norm(o, sub_g) * (1.0 - lam_init)
    return o.reshape(b, s, D_B)


def setup_inputs(seed: int = 0) -> dict:
    key = jax.random.key(seed)
    ks = iter(jax.random.split(key, 32))
    L = DEPTH

    def nrm(shape, scale):
        return jax.random.normal(next(ks), shape, jnp.float32) * scale

    def gain(shape):
        return 1.0 + nrm(shape, 0.02)

    return {
        'x': nrm((BATCH, SEQ, D_MODEL), 1.0),
        'norm_ffn1': gain((L, D_MODEL)),
        'ffn1_in': nrm((L, D_MODEL, 2 * D_FF), D_MODEL ** -0.5),
        'ffn1_out': nrm((L, D_FF, D_MODEL), D_FF ** -0.5),
        'norm_mix': gain((L, D_MODEL)),
        'w_in': nrm((L, D_MODEL, C_IN), D_MODEL ** -0.5),
        'rwkv_mu': jax.random.uniform(next(ks), (L, C_RWKV), jnp.float32),
        'decay_w0': nrm((L, N_DIR, D_A), 1.0),
        'decay_w2': nrm((L, N_DIR, LORA_DECAY, D_A), 0.5 * LORA_DECAY ** -0.5),
        'iclr_a0': nrm((L, N_DIR, D_A), 0.5),
        'iclr_a2': nrm((L, N_DIR, LORA_ICLR, D_A), 0.5 * LORA_ICLR ** -0.5),
        'gate_g2': nrm((L, LORA_GATE, D_A), LORA_GATE ** -0.5),
        'k_k': 0.85 + nrm((L, D_A), 0.05),
        'k_a': 1.0 + nrm((L, D_A), 0.05),
        'r_k': nrm((L, N_HEADS_A, HEAD_A), 0.1),
        'ln_x_g': gain((L, D_A)),
        'ln_x_b': nrm((L, D_A), 0.02),
        'q_gain': gain((L, HEAD_B)),
        'k_gain': gain((L, HEAD_B)),
        'diff_lambda': nrm((L, 4, HEAD_B), 0.1),
        'subln_g': gain((L, 2 * HEAD_B)),
        'w_branch': nrm((L, N_BRANCH, D_A, D_MODEL), D_A ** -0.5),
        'w_out': nrm((L, D_MODEL, D_MODEL), D_MODEL ** -0.5),
        'norm_ffn2': gain((L, D_MODEL)),
        'ffn2_in': nrm((L, D_MODEL, 2 * D_FF), D_MODEL ** -0.5),
        'ffn2_out': nrm((L, D_FF, D_MODEL), D_FF ** -0.5),
    }


def reference(x, norm_ffn1, ffn1_in, ffn1_out, norm_mix, w_in, rwkv_mu, decay_w0, decay_w2,
              iclr_a0, iclr_a2, gate_g2, k_k, k_a, r_k, ln_x_g, ln_x_b, q_gain, k_gain,
              diff_lambda, subln_g, w_branch, w_out, norm_ffn2, ffn2_in, ffn2_out):
    b, s, d = x.shape
    for l in range(DEPTH):
        lam_init = 0.8 - 0.6 * math.exp(-0.3 * l)
        x = x + 0.5 * swiglu(rms_norm(x, norm_ffn1[l]), ffn1_in[l], ffn1_out[l])
        h = rms_norm(x, norm_mix[l])
        proj = h @ w_in[l]
        p_rwkv, p_attn, p_gate = jnp.split(proj, [C_RWKV, C_RWKV + C_ATTN], axis=-1)
        o_a = rwkv7_mixer(p_rwkv, rwkv_mu[l], decay_w0[l], decay_w2[l], iclr_a0[l],
                          iclr_a2[l], gate_g2[l], k_k[l], k_a[l], r_k[l],
                          ln_x_g[l], ln_x_b[l]).astype(x.dtype)
        o_b = diff_attention(p_attn, q_gain[l], k_gain[l], diff_lambda[l], subln_g[l],
                             lam_init).astype(x.dtype)
        branches = jnp.stack([o_a, o_b], axis=2)
        y = jnp.einsum('bsgc,gcd->bsgd', branches, w_branch[l])
        gates = jax.nn.sigmoid(p_gate.reshape(b, s, N_BRANCH, d))
        merged = jnp.sum(gates * y, axis=2)
        x = x + merged @ w_out[l]
        x = x + 0.5 * swiglu(rms_norm(x, norm_ffn2[l]), ffn2_in[l], ffn2_out[l])
    return x
```

```cpp
#include <hip/hip_runtime.h>
#include <hip/hip_cooperative_groups.h>
#include <cstdio>
#include <cstdint>
namespace cg = cooperative_groups;
__device__ __forceinline__ int tid_opaque() { int t = (int)threadIdx.x; asm volatile("" : "+v"(t)); return t; }
__device__ __forceinline__ int bid_opaque() { int t = (int)blockIdx.x; asm volatile("" : "+s"(t)); return t; }
namespace pg8 {
#define PG8_LAS __attribute__((address_space(3)))
typedef unsigned short bf16_t;
typedef short bf16x8 __attribute__((ext_vector_type(8)));
typedef float f32x4 __attribute__((ext_vector_type(4)));
typedef unsigned u32x4 __attribute__((ext_vector_type(4)));
constexpr int BM = 256, BK = 64, HALF = 128, HTB = HALF * BK * 2  , STAGE_BYTES = 8 * HTB, NXCD = 8, WGM = 8;

__host__ __device__ __forceinline__ int lds_byte(int r, int c) { const int st = (r >> 4) * 2 + (c >> 5), rr = r & 15, cc = c & 31, ob = rr * 64 + cc * 2; return st * 1024 + (ob ^ (((ob >> 9) & 1) << 5)); }
__host__ __device__ __forceinline__ void stage_rc(int b, int& R, int& C) { const int st = b / 1024, sb = b % 1024, swz = sb ^ (((sb >> 9) & 1) << 5); R = (st >> 1) * 16 + swz / 64; C = (st & 1) * 32 + (swz % 64) / 2; }
__host__ __device__ __forceinline__ int perm32(int rho) { const int n = rho >> 4, i = rho & 15; return 8 * (i >> 2) + 4 * n + (i & 3); }

struct Unit { int pm, pn; };
struct Gemm { const bf16_t* A; const bf16_t* Bt; int M, N, K; };

struct StaticOrder {
    int nM, nN, nwg, G, c;
    __host__ __device__ void init(int M, int N, int G_, int c_) { nM = M / BM; nN = N / BM; nwg = nM * nN; G = G_; c = c_; }
    __host__ __device__ bool next(int i, Unit& u) const {
        const long L = (long)i * G + c; if (L >= nwg) return false;
        int wgid = (int)L; { const int q = nwg / NXCD, r = nwg % NXCD, xcd = wgid % NXCD, off = wgid / NXCD; wgid = (xcd < r ? xcd * (q + 1) : r * (q + 1) + (xcd - r) * q) + off; }
        const int nig = WGM * nN, gid = wgid / nig, fm = gid * WGM, gsz = (nM - fm) < WGM ? (nM - fm) : WGM;
        u.pm = fm + ((wgid % nig) % gsz); u.pn = (wgid % nig) / gsz; return true;
    }
    __device__ __forceinline__ void a_ready(const Unit&) const {}
    __device__ __forceinline__ void done(const Unit&) const {}
};

__device__ __forceinline__ unsigned cvt_pk_bf16(float lo, float hi) { unsigned r; asm volatile("v_cvt_pk_bf16_f32 %0, %1, %2" : "=v"(r) : "v"(lo), "v"(hi)); return r; }
template <class Epi, class Sched, bool ALIGN_EPI = false, bool SP2 = false>
__device__ __forceinline__ void gemm_phase(PG8_LAS unsigned char* lds, const Gemm g, const Sched& S, const Epi& E) {
    const int tid = tid_opaque(), wid = __builtin_amdgcn_readfirstlane(tid >> 6), lane = tid & 63, wr = wid >> 2, wc = wid & 3, fr = lane & 15, fq = lane >> 4;
    const int K = g.K, nt = K / BK;
    unsigned voffA[2], voffB[2];
#pragma unroll
    for (int i = 0; i < 2; ++i) { int R, C; stage_rc(tid * 16 + i * 8192, R, C); const int Rb = Epi::PERM ? ((R & ~31) + perm32(R & 31)) : R;
        voffA[i] = (unsigned)(R * K + C) * 2u; voffB[i] = (unsigned)(Rb * K + C) * 2u; }
    const size_t kstep = (size_t)(BK * 2);
    const size_t hstep = (size_t)HALF * K * 2;
    const size_t tstep = 2 * hstep;
    const unsigned ldsw = (unsigned)wid * 1024u;
    const int aoff = lds_byte(wr * 64 + fr, fq * 8), boff = lds_byte(wc * 32 + fr, fq * 8);
#define PG8_SA(b, h) (((b) * 2 + (h)) * HTB)
#define PG8_SB(b, h) ((4 + (b) * 2 + (h)) * HTB)
#define PG8_STAGE(bufoff, gbase, voff) do { _Pragma("unroll") for (int _i = 0; _i < 2; ++_i) \
        __builtin_amdgcn_global_load_lds((const unsigned*)((const char*)(gbase) + (voff)[_i]), (PG8_LAS unsigned*)(lds + (bufoff) + ldsw + _i * 8192), 16, 0, 0); } while (0)
#define PG8_LDA(dst, b, h) do { _Pragma("unroll") for (int m = 0; m < 4; ++m) _Pragma("unroll") for (int k = 0; k < 2; ++k) dst[m][k] = *(const PG8_LAS bf16x8*)(lds + PG8_SA(b, h) + aoff + m * 2048 + k * 1024); } while (0)
#define PG8_LDB(dst, b, h) do { _Pragma("unroll") for (int n = 0; n < 2; ++n) _Pragma("unroll") for (int k = 0; k < 2; ++k) dst[n][k] = *(const PG8_LAS bf16x8*)(lds + PG8_SB(b, h) + boff + n * 2048 + k * 1024); } while (0)
#define PG8_MMA(ai, bj, At, Bt) do { __builtin_amdgcn_s_setprio(1); _Pragma("unroll") for (int m = 0; m < 4; ++m) _Pragma("unroll") for (int n = 0; n < 2; ++n) _Pragma("unroll") for (int k = 0; k < 2; ++k) \
        acc[ai][bj][m][n] = __builtin_amdgcn_mfma_f32_16x16x32_bf16(Bt[n][k], At[m][k], acc[ai][bj][m][n], 0, 0, 0); __builtin_amdgcn_s_setprio(0); } while (0)
#define PG8_WAIT_V(n) asm volatile("s_waitcnt vmcnt(" #n ")" ::: "memory")
#define PG8_WAIT_L(n) asm volatile("s_waitcnt lgkmcnt(" #n ")" ::: "memory")
#define PG8_BAR __builtin_amdgcn_s_barrier()
#define PG8_SCHED __builtin_amdgcn_sched_barrier(0)
    Unit cur, nxt; int ui = 0;
    if (!S.next(0, cur)) return;
    f32x4 acc[2][2][4][2];
#pragma unroll
    for (int a = 0; a < 2; ++a)
#pragma unroll
        for (int b = 0; b < 2; ++b)
#pragma unroll
            for (int m = 0; m < 4; ++m)
#pragma unroll
                for (int n = 0; n < 2; ++n) acc[a][b][m][n] = (f32x4){0.f, 0.f, 0.f, 0.f};
    bf16x8 At[4][2], B0[2][2], B1[2][2];
    const char* cA = (const char*)g.A + (size_t)cur.pm * tstep; const char* cB = (const char*)g.Bt + (size_t)cur.pn * tstep;
    S.a_ready(cur);
    if constexpr (SP2) {
        PG8_STAGE(PG8_SB(0, 0), cB, voffB); PG8_STAGE(PG8_SB(0, 1), cB + hstep, voffB); PG8_STAGE(PG8_SA(0, 0), cA, voffA); PG8_STAGE(PG8_SA(0, 1), cA + hstep, voffA);
        if (wr == 1) PG8_BAR;
        PG8_WAIT_V(2); PG8_BAR;
        PG8_STAGE(PG8_SB(1, 0), cB + kstep, voffB); PG8_STAGE(PG8_SA(1, 0), cA + kstep, voffA); PG8_STAGE(PG8_SB(1, 1), cB + hstep + kstep, voffB);
        PG8_WAIT_V(6); PG8_BAR;
    } else {
        PG8_STAGE(PG8_SB(0, 0), cB, voffB); PG8_STAGE(PG8_SA(0, 0), cA, voffA); PG8_STAGE(PG8_SB(0, 1), cB + hstep, voffB); PG8_STAGE(PG8_SA(0, 1), cA + hstep, voffA);
        if (wr == 1) PG8_BAR;
        PG8_WAIT_V(4); PG8_BAR;
        PG8_STAGE(PG8_SB(1, 0), cB + kstep, voffB); PG8_STAGE(PG8_SA(1, 0), cA + kstep, voffA); PG8_STAGE(PG8_SB(1, 1), cB + hstep + kstep, voffB);
        PG8_WAIT_V(6); PG8_BAR;
    }
    for (;;) {
        const bool has_next = S.next(ui + 1, nxt);
        const char* nA = has_next ? (const char*)g.A + (size_t)nxt.pm * tstep : cA; const char* nB = has_next ? (const char*)g.Bt + (size_t)nxt.pn * tstep : cB;
        for (int t = 0; t < nt; t += 2) {
            const bool last = (t == nt - 2);
            const char* a1 = cA + (size_t)(t + 1) * kstep;
            const char* a2 = last ? nA : cA + (size_t)(t + 2) * kstep; const char* b2 = last ? nB : cB + (size_t)(t + 2) * kstep;
            const char* a3 = a2 + kstep; const char* b3 = b2 + kstep;
            if (last && has_next) S.a_ready(nxt);
            if constexpr (SP2) {
            PG8_LDB(B0, 0, 0); PG8_LDB(B1, 0, 1); PG8_SCHED; PG8_LDA(At, 0, 0); PG8_STAGE(PG8_SA(1, 1), a1 + hstep, voffA);
            PG8_WAIT_V(8); PG8_WAIT_L(0); PG8_BAR; PG8_MMA(0, 0, At, B0); PG8_MMA(0, 1, At, B1); PG8_BAR; PG8_SCHED;
            PG8_LDA(At, 0, 1); PG8_STAGE(PG8_SB(0, 0), b2, voffB); PG8_STAGE(PG8_SB(0, 1), b2 + hstep, voffB); PG8_STAGE(PG8_SA(0, 0), a2, voffA);
            PG8_WAIT_V(8); PG8_WAIT_L(0); PG8_BAR; PG8_MMA(1, 0, At, B0); PG8_MMA(1, 1, At, B1); PG8_BAR; PG8_SCHED;
            PG8_LDB(B0, 1, 0); PG8_LDB(B1, 1, 1); PG8_SCHED; PG8_LDA(At, 1, 0); PG8_STAGE(PG8_SA(0, 1), a2 + hstep, voffA);
            PG8_WAIT_V(8); PG8_WAIT_L(0); PG8_BAR; PG8_MMA(0, 0, At, B0); PG8_MMA(0, 1, At, B1); PG8_BAR; PG8_SCHED;
            PG8_LDA(At, 1, 1); PG8_STAGE(PG8_SB(1, 0), b3, voffB); PG8_STAGE(PG8_SB(1, 1), b3 + hstep, voffB); PG8_STAGE(PG8_SA(1, 0), a3, voffA);
            PG8_WAIT_V(8); PG8_WAIT_L(0); PG8_BAR; PG8_MMA(1, 0, At, B0); PG8_MMA(1, 1, At, B1); PG8_BAR; PG8_SCHED;
            } else {
            PG8_LDB(B0, 0, 0); PG8_SCHED; PG8_LDA(At, 0, 0); PG8_STAGE(PG8_SA(1, 1), a1 + hstep, voffA);
            PG8_WAIT_L(8); PG8_BAR; PG8_WAIT_L(0); PG8_MMA(0, 0, At, B0); PG8_BAR; PG8_SCHED;
            PG8_LDB(B1, 0, 1); PG8_STAGE(PG8_SB(0, 0), b2, voffB);
            PG8_BAR; PG8_WAIT_L(0); PG8_MMA(0, 1, At, B1); PG8_BAR;
            PG8_LDA(At, 0, 1); PG8_STAGE(PG8_SA(0, 0), a2, voffA);
            PG8_BAR; PG8_WAIT_L(0); PG8_MMA(1, 0, At, B0); PG8_BAR; PG8_SCHED;
            PG8_STAGE(PG8_SB(0, 1), b2 + hstep, voffB);
            PG8_WAIT_V(6); PG8_BAR; PG8_MMA(1, 1, At, B1); PG8_BAR;
            PG8_LDB(B0, 1, 0); PG8_SCHED; PG8_LDA(At, 1, 0); PG8_STAGE(PG8_SA(0, 1), a2 + hstep, voffA);
            PG8_WAIT_L(8); PG8_BAR; PG8_WAIT_L(0); PG8_MMA(0, 0, At, B0); PG8_BAR; PG8_SCHED;
            PG8_LDB(B1, 1, 1); PG8_STAGE(PG8_SB(1, 0), b3, voffB);
            PG8_BAR; PG8_WAIT_L(0); PG8_MMA(0, 1, At, B1); PG8_BAR;
            PG8_LDA(At, 1, 1); PG8_STAGE(PG8_SA(1, 0), a3, voffA);
            PG8_BAR; PG8_WAIT_L(0); PG8_MMA(1, 0, At, B0); PG8_BAR; PG8_SCHED;
            PG8_STAGE(PG8_SB(1, 1), b3 + hstep, voffB);
            PG8_WAIT_V(6); PG8_BAR; PG8_MMA(1, 1, At, B1); PG8_BAR;
            }
        }
        if constexpr (ALIGN_EPI) { if (wr == 0) PG8_BAR; }
        if constexpr (!Epi::AFTER_DRAIN) { E(acc, cur, wr, wc, fr, fq); S.done(cur); }
        if (!has_next) break;
#pragma unroll
        for (int a = 0; a < 2; ++a)
#pragma unroll
            for (int b = 0; b < 2; ++b)
#pragma unroll
                for (int m = 0; m < 4; ++m)
#pragma unroll
                    for (int n = 0; n < 2; ++n) acc[a][b][m][n] = (f32x4){0.f, 0.f, 0.f, 0.f};
        cur = nxt; cA = nA; cB = nB; ++ui;
        if constexpr (ALIGN_EPI) { if (wr == 1) PG8_BAR; }
    }
    PG8_WAIT_V(0);
    if constexpr (!ALIGN_EPI) { if (wr == 0) PG8_BAR; }
    PG8_BAR;
    if constexpr (Epi::AFTER_DRAIN) { E.fused(acc, cur, wr, wc, fr, fq, lds, wid, lane); S.done(cur); }
#undef PG8_SA
#undef PG8_SB
#undef PG8_STAGE
#undef PG8_LDA
#undef PG8_LDB
#undef PG8_MMA
#undef PG8_WAIT_V
#undef PG8_WAIT_L
#undef PG8_BAR
#undef PG8_SCHED
}
}
typedef unsigned short bf16_t;
typedef short bf16x8 __attribute__((ext_vector_type(8)));
typedef short s16x4 __attribute__((ext_vector_type(4)));
typedef float f32x4 __attribute__((ext_vector_type(4)));
typedef float f32x16 __attribute__((ext_vector_type(16)));
typedef unsigned u32x4 __attribute__((ext_vector_type(4)));
typedef unsigned u32x2 __attribute__((ext_vector_type(2)));
#define LAS __attribute__((address_space(3)))

constexpr int T = 16384, SEQ = 8192, DM = 1024, DFF = 2816, NFF = 5632, CIN_SRC = 5504, NWIN = 5632, NLORA = 2560, KLORA = 384;
constexpr int NPH = 15, DEPTH = 4;
constexpr float LOG2E = 1.4426950408889634f;
constexpr size_t MiB = 1u << 20;
constexpr size_t WS_CTL = 0;
constexpr size_t WS_WA = 1 * MiB;
constexpr size_t WS_WB = 13 * MiB;
constexpr size_t WS_WL = 438 * MiB;
constexpr size_t WS_WR = 440 * MiB;
constexpr size_t WS_WO = 444 * MiB;
constexpr size_t WS_XN = 22 * MiB;
constexpr size_t WS_ACT = 54 * MiB;
constexpr size_t WS_H = WS_ACT;
constexpr size_t WS_PR = WS_ACT;
constexpr size_t WS_WF = WS_ACT, WS_WBK = WS_ACT + 32 * MiB, WS_AO = WS_ACT;
constexpr size_t WS_QKV = WS_ACT + 64 * MiB;
constexpr size_t WS_G = WS_ACT + 112 * MiB;
constexpr size_t WS_R = WS_ACT + 176 * MiB, WS_K = WS_R + 16 * MiB, WS_V = WS_R + 32 * MiB, WS_KK = WS_R + 48 * MiB;
constexpr size_t WS_AF = WS_ACT + 240 * MiB, WS_AB = WS_AF + 16 * MiB;
constexpr size_t WS_GATE = WS_ACT + 272 * MiB;
constexpr size_t WS_YF = WS_ACT + 320 * MiB, WS_YB = WS_YF + 16 * MiB;
constexpr size_t WS_LIN = WS_YF;
constexpr size_t WS_O0 = WS_ACT + 352 * MiB, WS_O1 = WS_O0 + 16 * MiB;
constexpr size_t WS_PT = WS_XN;
constexpr size_t WS_LC = WS_ACT + 288 * MiB;
constexpr size_t WS_END = 447 * MiB;
static_assert(WS_ACT + 384 * MiB == WS_WL, "mixer weights sit right after the activation map");
constexpr int LDS_BYTES = 131072 + 1024;

static_assert(WS_WBK == WS_WF + 32 * MiB && WS_AB == WS_AF + 16 * MiB && WS_GATE == WS_AF + 32 * MiB, "contiguous outputs");
struct Params { const float* in[26]; float* out; unsigned char* ws; int ph_lo, ph_hi; };

__device__ __forceinline__ float bf2f(unsigned short u) { return __uint_as_float(((unsigned)u) << 16); }
__device__ __forceinline__ float bflo(unsigned w) { return __uint_as_float(w << 16); }
__device__ __forceinline__ float bfhi(unsigned w) { return __uint_as_float(w & 0xffff0000u); }
typedef float f32x2n __attribute__((ext_vector_type(2)));
typedef __bf16 bf16x2n __attribute__((ext_vector_type(2)));
__device__ __forceinline__ unsigned pk2(float lo, float hi) { f32x2n v = {lo, hi}; return __builtin_bit_cast(unsigned, __builtin_convertvector(v, bf16x2n)); }
__device__ __forceinline__ unsigned short f2bf(float f) { return (unsigned short)(pk2(f, 0.f) & 0xffffu); }
__device__ __forceinline__ float sigm(float x) { return 1.0f / (1.0f + __expf(-x)); }
__device__ __forceinline__ void unpack8(u32x4 w, float* f) { f[0] = bflo(w.x); f[1] = bfhi(w.x); f[2] = bflo(w.y); f[3] = bfhi(w.y); f[4] = bflo(w.z); f[5] = bfhi(w.z); f[6] = bflo(w.w); f[7] = bfhi(w.w); }
__device__ __forceinline__ u32x4 pack8(const float* f) { u32x4 w; w.x = pk2(f[0], f[1]); w.y = pk2(f[2], f[3]); w.z = pk2(f[4], f[5]); w.w = pk2(f[6], f[7]); return w; }
__device__ __forceinline__ float wave_sum(float v) { v += __shfl_xor(v, 32); v += __shfl_xor(v, 16); v += __shfl_xor(v, 8); v += __shfl_xor(v, 4); v += __shfl_xor(v, 2); v += __shfl_xor(v, 1); return v; }

struct EpiSwiGLU {
    static constexpr bool PERM = true, AFTER_DRAIN = false;
    bf16_t* H;
    __device__ __forceinline__ void operator()(const f32x4 (&acc)[2][2][4][2], const pg8::Unit& u, int wr, int wc, int fr, int fq) const {
        const int row0 = u.pm * 256 + wr * 64 + fr, col0 = u.pn * 128 + wc * 32 + 8 * fq;
#pragma unroll
        for (int ai = 0; ai < 2; ++ai)
#pragma unroll
            for (int m = 0; m < 4; ++m) {
                float o[8];
#pragma unroll
                for (int n = 0; n < 2; ++n)
#pragma unroll
                    for (int j = 0; j < 4; ++j) { const float g = acc[ai][0][m][n][j], up = acc[ai][1][m][n][j]; o[4 * n + j] = g * up * __builtin_amdgcn_rcpf(1.0f + __builtin_amdgcn_exp2f(-g * LOG2E)); }
                *(u32x4*)(H + (size_t)(row0 + ai * 128 + m * 16) * DFF + col0) = pack8(o);
            }
    }
};
struct EpiResid {
    static constexpr bool PERM = false, AFTER_DRAIN = false;
    const float* base; float* out; float scale;
    __device__ __forceinline__ void operator()(const f32x4 (&acc)[2][2][4][2], const pg8::Unit& u, int wr, int wc, int fr, int fq) const {
        const int col0 = u.pn * 256 + wc * 32 + 4 * fq;
#pragma unroll
        for (int ai = 0; ai < 2; ++ai)
#pragma unroll
            for (int m = 0; m < 4; ++m) {
                const size_t off = (size_t)(u.pm * 256 + ai * 128 + wr * 64 + m * 16 + fr) * DM + col0;
#pragma unroll
                for (int bj = 0; bj < 2; ++bj)
#pragma unroll
                    for (int n = 0; n < 2; ++n) { const f32x4 b = *(const f32x4*)(base + off + bj * 128 + n * 16); *(f32x4*)(out + off + bj * 128 + n * 16) = b + acc[ai][bj][m][n] * scale; }
            }
    }
};
struct EpiWin {
    static constexpr bool PERM = true, AFTER_DRAIN = false;
    bf16_t *PR, *QKV, *G;
    __device__ __forceinline__ void operator()(const f32x4 (&acc)[2][2][4][2], const pg8::Unit& u, int wr, int wc, int fr, int fq) const {
        const int row0 = u.pm * 256 + wr * 64 + fr; const int lc0 = wc * 32 + 8 * fq;
        bf16_t* base; int ld, colt; bool sg = false;
        if (u.pn < 8) { base = PR; ld = 2048; colt = u.pn * 256; } else if (u.pn < 14) { base = QKV; ld = 1536; colt = (u.pn - 8) * 256; } else { base = G; ld = 2048; colt = (u.pn - 14) * 256; sg = true; }
#pragma unroll
        for (int ai = 0; ai < 2; ++ai)
#pragma unroll
            for (int m = 0; m < 4; ++m) {
                bf16_t* rowp = base + (size_t)(row0 + ai * 128 + m * 16) * ld + colt + lc0;
#pragma unroll
                for (int bj = 0; bj < 2; ++bj) { float o[8];
#pragma unroll
                    for (int n = 0; n < 2; ++n)
#pragma unroll
                        for (int j = 0; j < 4; ++j) { float v = acc[ai][bj][m][n][j]; if (sg) v = __builtin_amdgcn_rcpf(1.0f + __builtin_amdgcn_exp2f(-v * LOG2E)); o[4 * n + j] = v; }
                    *(u32x4*)(rowp + bj * 128) = pack8(o); }
            }
    }
};
struct EpiDecay {
    static constexpr bool PERM = true, AFTER_DRAIN = false;
    const float* w0; float *Wf, *Wb;
    __device__ __forceinline__ void operator()(const f32x4 (&acc)[2][2][4][2], const pg8::Unit& u, int wr, int wc, int fr, int fq) const {
        const int row0 = u.pm * 256 + wr * 64 + fr; const int g = u.pn >> 1; const int cb = (u.pn & 1) * 256 + wc * 32 + 8 * fq;
        float* Wd = Wf + (size_t)g * (32 * MiB / 4);
#pragma unroll
        for (int bj = 0; bj < 2; ++bj) {
            const int c = cb + bj * 128;
            const f32x4 z0 = *(const f32x4*)(w0 + g * 512 + c), z1 = *(const f32x4*)(w0 + g * 512 + c + 4);
#pragma unroll
            for (int ai = 0; ai < 2; ++ai)
#pragma unroll
                for (int m = 0; m < 4; ++m) { const size_t off = (size_t)(row0 + ai * 128 + m * 16) * 512 + c; f32x4 o0, o1;
#pragma unroll
                    for (int j = 0; j < 4; ++j) {
                        const float s0 = __builtin_amdgcn_rcpf(1.0f + __builtin_amdgcn_exp2f(-LOG2E * (z0[j] + acc[ai][bj][m][0][j])));
                        const float s1 = __builtin_amdgcn_rcpf(1.0f + __builtin_amdgcn_exp2f(-LOG2E * (z1[j] + acc[ai][bj][m][1][j])));
                        o0[j] = -0.6065306597126334f * s0; o1[j] = -0.6065306597126334f * s1; }
                    *(f32x4*)(Wd + off) = o0; *(f32x4*)(Wd + off + 4) = o1; }
        }
    }
};
struct EpiIclr {
    static constexpr bool PERM = true, AFTER_DRAIN = false;
    const float* a0; bf16_t *Af, *Ab, *GATE;
    __device__ __forceinline__ void operator()(const f32x4 (&acc)[2][2][4][2], const pg8::Unit& u, int wr, int wc, int fr, int fq) const {
        const int row0 = u.pm * 256 + wr * 64 + fr; const int kind = u.pn >> 1; const int cb = (u.pn & 1) * 256 + wc * 32 + 8 * fq;
        bf16_t* Bd = Af + (size_t)kind * (16 * MiB / 2); const bool sg = kind < 2;
#pragma unroll
        for (int bj = 0; bj < 2; ++bj) {
            const int c = cb + bj * 128;
            f32x4 z0 = (f32x4){0.f, 0.f, 0.f, 0.f}, z1 = z0;
            if (sg) { z0 = *(const f32x4*)(a0 + kind * 512 + c); z1 = *(const f32x4*)(a0 + kind * 512 + c + 4); }
#pragma unroll
            for (int ai = 0; ai < 2; ++ai)
#pragma unroll
                for (int m = 0; m < 4; ++m) { const size_t off = (size_t)(row0 + ai * 128 + m * 16) * 512 + c; float o[8];
#pragma unroll
                    for (int j = 0; j < 4; ++j) { o[j] = z0[j] + acc[ai][bj][m][0][j]; o[4 + j] = z1[j] + acc[ai][bj][m][1][j]; }
                    if (sg) {
#pragma unroll
                        for (int j = 0; j < 8; ++j) o[j] = __builtin_amdgcn_rcpf(1.0f + __builtin_amdgcn_exp2f(-LOG2E * o[j]));
                    }
                    *(u32x4*)(Bd + off) = pack8(o); }
        }
    }
};
struct EpiBranch {
    static constexpr bool PERM = true, AFTER_DRAIN = false;
    const bf16_t* G; bf16_t* MG;
    __device__ __forceinline__ void operator()(const f32x4 (&acc)[2][2][4][2], const pg8::Unit& u, int wr, int wc, int fr, int fq) const {
        const int row0 = u.pm * 256 + wr * 64 + fr, c = u.pn * 128 + wc * 32 + 8 * fq;
#pragma unroll
        for (int ai = 0; ai < 2; ++ai)
#pragma unroll
            for (int m = 0; m < 4; ++m) { const size_t r = (size_t)(row0 + ai * 128 + m * 16);
                float g0[8], g1[8], o[8]; unpack8(*(const u32x4*)(G + r * 2048 + c), g0); unpack8(*(const u32x4*)(G + r * 2048 + 1024 + c), g1);
#pragma unroll
                for (int n = 0; n < 2; ++n)
#pragma unroll
                    for (int j = 0; j < 4; ++j) o[4 * n + j] = g0[4 * n + j] * acc[ai][0][m][n][j] + g1[4 * n + j] * acc[ai][1][m][n][j];
                *(u32x4*)(MG + r * 1024 + c) = pack8(o); asm volatile("" ::: "memory"); }
    }
};
__device__ __forceinline__ void cvt_tile(unsigned char* lds, const float* src, int ld, int n_begin, int K, bf16_t* dst, int Kd, int koff, int mode, int roff, int t, int tid) {
    const int ntk = Kd / 64; unsigned short* tile = (unsigned short*)lds;
    const int tn = t / ntk, tk = t - tn * ntk; const int n0 = tn * 64, k0 = tk * 64;
    const bool valid = (src != nullptr) && (k0 >= koff) && (k0 < koff + K);
    __syncthreads();
    if (valid) {
#pragma unroll
        for (int it = 0; it < 2; ++it) { const int idx = tid + 512 * it, kr = idx >> 4, nc4 = idx & 15;
            const f32x4 v = *(const f32x4*)(src + (size_t)(k0 - koff + kr) * ld + n_begin + n0 + 4 * nc4);
#pragma unroll
            for (int j = 0; j < 4; ++j) tile[(4 * nc4 + j) * 66 + kr] = f2bf(v[j]); }
    }
    __syncthreads();
    { const int n = tid >> 3, kc = (tid & 7) * 8; u32x4 w = (u32x4){0u, 0u, 0u, 0u};
      if (valid) { const unsigned* tp = (const unsigned*)(tile + n * 66 + kc); w.x = tp[0]; w.y = tp[1]; w.z = tp[2]; w.w = tp[3]; }
      const int nl = n0 + n; const int drow = (mode == 0) ? (nl + roff) : (256 * (nl >> 7) + (nl & 127) + roff);
      *(u32x4*)(dst + (size_t)drow * Kd + k0 + kc) = w; }
}
__device__ __forceinline__ void cvt_job(unsigned char* lds, const float* src, int ld, int n_begin, int n_count, int K, bf16_t* dst, int Kd, int koff, int mode, int roff, int& cum) {
    const int tid = tid_opaque(), G = gridDim.x; const int bid = bid_opaque();
    const int ntiles = (n_count / 64) * (Kd / 64);
    const int start = (int)(((unsigned)bid + (unsigned)G - (unsigned)(cum % G)) % (unsigned)G);
    for (int t = start; t < ntiles; t += G) cvt_tile(lds, src, ld, n_begin, K, dst, Kd, koff, mode, roff, t, tid);
    cum += ntiles;
}
constexpr int CVT_FFN_TILES = 3 * 704;
__device__ __forceinline__ void cvt_ffn_tile(unsigned char* lds, unsigned char* ws, const float* w_in, const float* w_out, int gt, int tid) {
    bf16_t* WA = (bf16_t*)(ws + WS_WA); bf16_t* WB = (bf16_t*)(ws + WS_WB);
    if (gt < 704) cvt_tile(lds, w_in, NFF, 0, DM, WA, DM, 0, 1, 0, gt, tid);
    else if (gt < 1408) cvt_tile(lds, w_in, NFF, DFF, DM, WA, DM, 0, 1, 128, gt - 704, tid);
    else cvt_tile(lds, w_out, DM, 0, DFF, WB, DFF, 0, 0, 0, gt - 1408, tid);
}
__device__ void cvt_ffn(unsigned char* lds, unsigned char* ws, const float* w_in, const float* w_out) {
    int cum = 0; bf16_t* WA = (bf16_t*)(ws + WS_WA); bf16_t* WB = (bf16_t*)(ws + WS_WB);
    cvt_job(lds, w_in, NFF, 0, DFF, DM, WA, DM, 0, 1, 0, cum);
    cvt_job(lds, w_in, NFF, DFF, DFF, DM, WA, DM, 0, 1, 128, cum);
    cvt_job(lds, w_out, DM, 0, DM, DFF, WB, DFF, 0, 0, 0, cum);
}
__device__ void cvt_mixer(unsigned char* lds, unsigned char* ws, const float* w_in, const float* dw2, const float* ia2, const float* gg2, const float* wbr, const float* wout) {
    int cum = 0; bf16_t* WA = (bf16_t*)(ws + WS_WA); bf16_t* WL = (bf16_t*)(ws + WS_WL); bf16_t* WR = (bf16_t*)(ws + WS_WR); bf16_t* WO = (bf16_t*)(ws + WS_WO);
    cvt_job(lds, w_in, CIN_SRC, 0, 1920, DM, WA, DM, 0, 0, 0, cum);
    cvt_job(lds, nullptr, 0, 0, 128, 0, WA, DM, 0, 0, 1920, cum);
    cvt_job(lds, w_in, CIN_SRC, 1920, 3584, DM, WA, DM, 0, 0, 2048, cum);
    cvt_job(lds, dw2, 512, 0, 512, 64, WL, KLORA, 0, 0, 0, cum);
    cvt_job(lds, dw2 + 64 * 512, 512, 0, 512, 64, WL, KLORA, 64, 0, 512, cum);
    cvt_job(lds, ia2, 512, 0, 512, 64, WL, KLORA, 128, 0, 1024, cum);
    cvt_job(lds, ia2 + 64 * 512, 512, 0, 512, 64, WL, KLORA, 192, 0, 1536, cum);
    cvt_job(lds, gg2, 512, 0, 512, 128, WL, KLORA, 256, 0, 2048, cum);
    cvt_job(lds, wbr, DM, 0, DM, 512, WR, DM, 0, 1, 0, cum);
    cvt_job(lds, wbr + 512 * DM, DM, 0, DM, 512, WR, DM, 512, 1, 128, cum);
    cvt_job(lds, wout, DM, 0, DM, DM, WO, DM, 0, 0, 0, cum);
}
__device__ void norm_rows(const float* x, const float* g, bf16_t* xn) {
    const int tid_ = tid_opaque(); const int lane = tid_ & 63, gw = bid_opaque() * 8 + (tid_ >> 6), nw = gridDim.x * 8;
    f32x4 gv[4];
#pragma unroll
    for (int i = 0; i < 4; ++i) gv[i] = *(const f32x4*)(g + 4 * lane + 256 * i);
    f32x4 nx[4];
#pragma unroll
    for (int i = 0; i < 4; ++i) nx[i] = (gw < T) ? *(const f32x4*)(x + (size_t)gw * DM + 4 * lane + 256 * i) : (f32x4){0.f, 0.f, 0.f, 0.f};
    for (int row = gw; row < T; row += nw) {
        f32x4 v[4]; float ss = 0.f;
#pragma unroll
        for (int i = 0; i < 4; ++i) { v[i] = nx[i]; ss += v[i][0] * v[i][0] + v[i][1] * v[i][1] + v[i][2] * v[i][2] + v[i][3] * v[i][3]; }
        if (row + nw < T) {
#pragma unroll
            for (int i = 0; i < 4; ++i) nx[i] = *(const f32x4*)(x + (size_t)(row + nw) * DM + 4 * lane + 256 * i);
        }
        ss = wave_sum(ss); const float rs = rsqrtf(ss * (1.0f / 1024.0f) + 1e-6f);
#pragma unroll
        for (int i = 0; i < 4; ++i) { u32x2 w; w.x = pk2(v[i][0] * rs * gv[i][0], v[i][1] * rs * gv[i][1]); w.y = pk2(v[i][2] * rs * gv[i][2], v[i][3] * rs * gv[i][3]);
            *(u32x2*)(xn + (size_t)row * DM + 4 * lane + 256 * i) = w; }
    }
}
__device__ void prep_phase(const Params& P, int l) {
    unsigned char* ws = P.ws;
    const bf16_t* PR = (const bf16_t*)(ws + WS_PR); bf16_t* QKV = (bf16_t*)(ws + WS_QKV);
    bf16_t* R = (bf16_t*)(ws + WS_R); bf16_t* Kb = (bf16_t*)(ws + WS_K); bf16_t* V = (bf16_t*)(ws + WS_V); bf16_t* KK = (bf16_t*)(ws + WS_KK); bf16_t* LIN = (bf16_t*)(ws + WS_LIN);
    const float* mu = P.in[6] + l * 1920; const float* k_k = P.in[12] + l * 512; const float* qg = P.in[17] + l * 64; const float* kg = P.in[18] + l * 64;
    const int tid_ = tid_opaque(); const int lane = tid_ & 63, gw = bid_opaque() * 8 + (tid_ >> 6), nw = gridDim.x * 8;
    f32x4 muA[4], muB[4];
#pragma unroll
    for (int i = 0; i < 4; ++i) { const int ch = lane + 64 * i; const int c0 = ch < 240 ? 8 * ch : 0; muA[i] = *(const f32x4*)(mu + c0); muB[i] = *(const f32x4*)(mu + c0 + 4); }
    const f32x4 kkA = *(const f32x4*)(k_k + 8 * lane), kkB = *(const f32x4*)(k_k + 8 * lane + 4);
    const f32x4 g0 = *(const f32x4*)(qg + ((8 * lane) & 63)), g1 = *(const f32x4*)(qg + ((8 * lane) & 63) + 4), h0 = *(const f32x4*)(kg + ((8 * lane) & 63)), h1 = *(const f32x4*)(kg + ((8 * lane) & 63) + 4);
    const int tpw = (T + nw - 1) / nw; const int tbeg = gw * tpw, tend = (tbeg + tpw < T) ? tbeg + tpw : T;
    int coff[4];
#pragma unroll
    for (int i = 0; i < 4; ++i) { const int ch = lane + 64 * i; coff[i] = ch < 240 ? 8 * ch : 0; }
    const u32x4 zero4 = (u32x4){0u, 0u, 0u, 0u};
    u32x4 rp[4], rc[4], rn[4], rnn[4];
#pragma unroll
    for (int i = 0; i < 4; ++i) { rp[i] = zero4; rc[i] = zero4; rn[i] = zero4; rnn[i] = zero4; }
    if (tbeg < tend) {
#pragma unroll
        for (int i = 0; i < 4; ++i) { const bf16_t* pr0 = PR + (size_t)tbeg * 2048 + coff[i]; rc[i] = *(const u32x4*)pr0;
            if (tbeg > 0) rp[i] = *(const u32x4*)(pr0 - 2048);
            if (tbeg + 1 < T) rn[i] = *(const u32x4*)(pr0 + 2048); }
    }
    u32x4 qnx = zero4, knx = zero4;
    if (tbeg < tend) { const bf16_t* qp0 = QKV + (size_t)tbeg * 1536 + 8 * lane; qnx = *(const u32x4*)qp0; knx = *(const u32x4*)(qp0 + 512); }
    for (int tok = tbeg; tok < tend; ++tok) {
        const int s = tok & (SEQ - 1);
        const bool has_nn = tok + 2 < T;
#pragma unroll
        for (int i = 0; i < 4; ++i) rnn[i] = has_nn ? *(const u32x4*)(PR + (size_t)(tok + 2) * 2048 + coff[i]) : zero4;
#pragma unroll
        for (int i = 0; i < 4; ++i) {
            const int ch = lane + 64 * i; const bool ok = ch < 240; const int c0 = ok ? 8 * ch : 0;
            float cur[8], prv[8], nxt[8], p[8];
            unpack8(rc[i], cur); unpack8(s > 0 ? rp[i] : zero4, prv); unpack8(s < SEQ - 1 ? rn[i] : zero4, nxt);
            const f32x4 m0 = muA[i], m1 = muB[i];
#pragma unroll
            for (int j = 0; j < 8; ++j) { const float m = j < 4 ? m0[j] : m1[j - 4]; p[j] = cur[j] + m * (0.5f * (prv[j] + nxt[j]) - cur[j]); }
            const bool isk = ok && c0 >= 512 && c0 < 1024; const int ck = isk ? c0 - 512 : 0;
            const f32x4 kk0 = kkA, kk1 = kkB;
            float kkv[8]; float ss = 0.f;
#pragma unroll
            for (int j = 0; j < 8; ++j) { kkv[j] = p[j] * (j < 4 ? kk0[j] : kk1[j - 4]); ss += kkv[j] * kkv[j]; }
            ss += __shfl_xor(ss, 1); ss += __shfl_xor(ss, 2); ss += __shfl_xor(ss, 4);
            const float inv = 1.0f / fmaxf(sqrtf(ss), 1e-12f);
            if (ok) {
                if (c0 < 512) *(u32x4*)(R + (size_t)tok * 512 + c0) = pack8(p);
                else if (c0 < 1024) { *(u32x4*)(Kb + (size_t)tok * 512 + ck) = pack8(p);
#pragma unroll
                    for (int j = 0; j < 8; ++j) kkv[j] *= inv;
                    *(u32x4*)(KK + (size_t)tok * 512 + ck) = pack8(kkv); }
                else if (c0 < 1536) *(u32x4*)(V + (size_t)tok * 512 + (c0 - 1024)) = pack8(p);
                else { float o[8];
                    if (c0 < 1664) { for (int j = 0; j < 8; ++j) o[j] = tanhf(p[j]); }
                    else if (c0 < 1792) { for (int j = 0; j < 8; ++j) o[j] = p[j]; }
                    else { for (int j = 0; j < 8; ++j) o[j] = sigm(p[j]); }
                    *(u32x4*)(LIN + (size_t)tok * KLORA + (c0 - 1536)) = pack8(o); }
            }
        }
        { const int c0 = 8 * lane; bf16_t* qp = QKV + (size_t)tok * 1536 + c0;
          float q[8], k[8]; unpack8(qnx, q); unpack8(knx, k);
          if (tok + 1 < tend) { qnx = *(const u32x4*)(qp + 1536); knx = *(const u32x4*)(qp + 1536 + 512); }
          float sq = 0.f, sk = 0.f;
#pragma unroll
          for (int j = 0; j < 8; ++j) { sq += q[j] * q[j]; sk += k[j] * k[j]; }
          sq += __shfl_xor(sq, 1); sq += __shfl_xor(sq, 2); sq += __shfl_xor(sq, 4); sk += __shfl_xor(sk, 1); sk += __shfl_xor(sk, 2); sk += __shfl_xor(sk, 4);
          const float rq = rsqrtf(sq * (1.0f / 64.0f) + 1e-6f) * (0.125f * LOG2E), rk = rsqrtf(sk * (1.0f / 64.0f) + 1e-6f);
#pragma unroll
          for (int j = 0; j < 8; ++j) { q[j] *= rq * (j < 4 ? g0[j] : g1[j - 4]); k[j] *= rk * (j < 4 ? h0[j] : h1[j - 4]); }
          *(u32x4*)qp = pack8(q); *(u32x4*)(qp + 512) = pack8(k); }
#pragma unroll
        for (int i = 0; i < 4; ++i) { rp[i] = rc[i]; rc[i] = rn[i]; rn[i] = rnn[i]; }
    }
}
namespace ck {
constexpr int LDP = 72, SLOT = 64 * LDP * 2;
__device__ __forceinline__ int crow(int r, int hi) { return (r & 3) + 8 * (r >> 2) + 4 * hi; }
__device__ __forceinline__ void ldf(const unsigned char* buf, int row0, int lane, bf16x8 (&f)[4]) {
    const unsigned char* p = buf + ((row0 + (lane & 31)) * LDP + 8 * (lane >> 5)) * 2;
#pragma unroll
    for (int s = 0; s < 4; ++s) f[s] = *(const bf16x8*)(p + 32 * s);
}
__device__ __forceinline__ void ldf_g(const bf16_t* g, int row0, int lane, bf16x8 (&f)[4]) {
    const bf16_t* p = g + (row0 + (lane & 31)) * 64 + 8 * (lane >> 5);
#pragma unroll
    for (int s = 0; s < 4; ++s) f[s] = *(const bf16x8*)(p + 16 * s);
}
__device__ __forceinline__ void mma4(f32x16& acc, const bf16x8 (&a)[4], const bf16x8 (&b)[4]) {
#pragma unroll
    for (int s = 0; s < 4; ++s) acc = __builtin_amdgcn_mfma_f32_32x32x16_bf16(a[s], b[s], acc, 0, 0, 0);
}
template <int MASK> __device__ __forceinline__ float mval(float v, int row, int col) { if (MASK == 1) return col < row ? v : 0.f; if (MASK == 2) return col <= row ? v : 0.f; return v; }
template <int MASK> __device__ __forceinline__ void st_n(unsigned char* buf, int m0, int n0, int lane, const f32x16& acc) {
    const int hi = lane >> 5, col = n0 + (lane & 31);
#pragma unroll
    for (int r = 0; r < 16; ++r) { const int row = m0 + crow(r, hi); *(unsigned short*)(buf + (row * LDP + col) * 2) = f2bf(mval<MASK>(acc[r], row, col)); }
}
template <int MASK> __device__ __forceinline__ void st_t(unsigned char* buf, int m0, int n0, int lane, const f32x16& acc) {
    const int hi = lane >> 5, col = n0 + (lane & 31);
#pragma unroll
    for (int g = 0; g < 4; ++g) { const int row = m0 + 8 * g + 4 * hi; u32x2 w;
        w.x = pk2(mval<MASK>(acc[4 * g + 0], row + 0, col), mval<MASK>(acc[4 * g + 1], row + 1, col)); w.y = pk2(mval<MASK>(acc[4 * g + 2], row + 2, col), mval<MASK>(acc[4 * g + 3], row + 3, col));
        *(u32x2*)(buf + (col * LDP + row) * 2) = w; }
}
__device__ __forceinline__ f32x16 zero16() { return f32x16{0.f, 0.f, 0.f, 0.f, 0.f, 0.f, 0.f, 0.f, 0.f, 0.f, 0.f, 0.f, 0.f, 0.f, 0.f, 0.f}; }

template <int MODE> __device__ void chunk_pass(unsigned char* lds, unsigned char* ws, const float* k_a) {
    const int tid = tid_opaque(), w = __builtin_amdgcn_readfirstlane(tid >> 6), lane0 = tid & 63;
    const int q = w & 3, m0 = (q >> 1) * 32, n0 = (q & 1) * 32;
    const int bid = bid_opaque();
#define SL(i) (lds + (i) * SLOT)
    float* segsum = (float*)(lds + 11 * SLOT); float* gC = segsum + 512; float* Lf = gC + 64; unsigned char* SC = (unsigned char*)(Lf + 4096);
    const bf16_t* R = (const bf16_t*)(ws + WS_R); const bf16_t* V = (const bf16_t*)(ws + WS_V); const bf16_t* KK = (const bf16_t*)(ws + WS_KK); const bf16_t* Kb = (const bf16_t*)(ws + WS_K);
    for (int ci = bid; ci < 4096; ci += (int)gridDim.x) {
        const int inst = ci >> 7, c = ci & 127, b = inst >> 4, h = (inst >> 1) & 7, dir = inst & 1;
        int lane = lane0; asm volatile("" : "+v"(lane)); const int hi = lane >> 5, l32 = lane & 31;
        const float* LW = (const float*)(ws + (dir ? WS_WBK : WS_WF)); const bf16_t* Ag = (const bf16_t*)(ws + (dir ? WS_AB : WS_AF));
        const int colbase = h * 64; const size_t tb = (size_t)b * SEQ;
        const float kav = k_a[colbase + lane];
        float kk[8], lw[8], a[8], kx[8], rr[8], vv[8];
#pragma unroll
        for (int i = 0; i < 8; ++i) { const int step = 64 * c + 8 * w + i; const size_t off = (tb + (size_t)(dir ? (SEQ - 1 - step) : step)) * 512 + colbase + lane;
            kk[i] = bf2f(KK[off]); lw[i] = LW[off]; a[i] = bf2f(Ag[off]); kx[i] = bf2f(Kb[off]); rr[i] = bf2f(R[off]); vv[i] = bf2f(V[off]); }
        float pf[8]; pf[0] = lw[0];
#pragma unroll
        for (int i = 1; i < 8; ++i) pf[i] = pf[i - 1] + lw[i];
        segsum[w * 64 + lane] = pf[7];
        __syncthreads();
        float offs = 0.f, tot = 0.f;
#pragma unroll
        for (int jj = 0; jj < 8; ++jj) { const float sv = segsum[jj * 64 + lane]; if (jj < w) offs += sv; tot += sv; }
        { float aT[8], b2T[8], k2T[8];
#pragma unroll
          for (int i = 0; i < 8; ++i) { const int t = 8 * w + i; const float Lt = offs + pf[i], Lp = Lt - lw[i];
              const float ea = __expf(Lp), eb = __expf(-Lt), ec = __expf(tot - Lt);
              const float bv = kk[i] * a[i], kd = kx[i] * (1.0f + (a[i] - 1.0f) * kav);
              const float alpha = -kk[i] * ea;
              *(unsigned short*)(SL(0) + (t * LDP + lane) * 2) = f2bf(alpha);
              *(unsigned short*)(SL(2) + (t * LDP + lane) * 2) = f2bf(bv * eb);
              *(unsigned short*)(SL(3) + (t * LDP + lane) * 2) = f2bf(kd * eb);
              if (MODE >= 1) *(unsigned short*)(SL(1) + (t * LDP + lane) * 2) = f2bf(rr[i] * __expf(Lt));
              aT[i] = alpha; b2T[i] = bv * ec; k2T[i] = kd * ec; }
          *(u32x4*)(SL(4) + (lane * LDP + 8 * w) * 2) = pack8(aT);
          *(u32x4*)(SL(5) + (lane * LDP + 8 * w) * 2) = pack8(vv);
          if (MODE != 1) { *(u32x4*)(SL(6) + (lane * LDP + 8 * w) * 2) = pack8(b2T); *(u32x4*)(SL(7) + (lane * LDP + 8 * w) * 2) = pack8(k2T); if (w == 0) gC[lane] = __expf(tot); } }
        __syncthreads();
        { bf16x8 fa[4], fb[4], fr[4];
          ldf(SL(0), m0, lane, fa); ldf(w < 4 ? SL(3) : SL(2), n0, lane, fb); if (MODE >= 1) ldf(SL(1), m0, lane, fr);
          f32x16 acc1 = zero16(), acc2 = zero16(); mma4(acc1, fa, fb); if (MODE >= 1) mma4(acc2, fr, fb);
          __syncthreads();
          if (w < 4) { st_n<1>(SL(8), m0, n0, lane, acc1); if (MODE >= 1) st_n<2>(SL(10), m0, n0, lane, acc2);
              for (int z = tid; z < 2 * (SLOT / 16); z += 256) *(u32x4*)(SL(2) + z * 16) = (u32x4){0u, 0u, 0u, 0u};
          } else {
#pragma unroll
              for (int r = 0; r < 16; ++r) { const int row = m0 + crow(r, hi), col = n0 + l32; acc1[r] = col < row ? acc1[r] : 0.f; Lf[row * 64 + col] = acc1[r]; }
              st_n<0>(SL(0), m0, n0, lane, acc1);
              if (MODE >= 1) st_n<2>(SL(9), m0, n0, lane, acc2); }
          __syncthreads(); }
        if (w == 0) {
            unsigned char* Tn = SL(3); unsigned char* Tt = SL(2);
            { const int bi = lane >> 4, cc = lane & 15; float tc[16];
#pragma unroll
              for (int t = 0; t < 16; ++t) { float v = (t == cc) ? 1.0f : 0.0f;
#pragma unroll
                  for (int jx = 0; jx < t; ++jx) v += Lf[(16 * bi + t) * 64 + 16 * bi + jx] * tc[jx];
                  tc[t] = v; *(unsigned short*)(Tn + ((16 * bi + t) * LDP + 16 * bi + cc) * 2) = f2bf(v); asm volatile("" ::: "memory"); }
              *(u32x4*)(Tt + ((16 * bi + cc) * LDP + 16 * bi) * 2) = pack8(tc); *(u32x4*)(Tt + ((16 * bi + cc) * LDP + 16 * bi + 8) * 2) = pack8(tc + 8); }
            asm volatile("s_waitcnt lgkmcnt(0)" ::: "memory");
            const int pr = l32 >> 4, i16 = l32 & 15;
            {
              const bf16x8 a1 = *(const bf16x8*)(SL(0) + ((32 * pr + 16 + i16) * LDP + 32 * pr + 8 * hi) * 2);
              const bf16x8 b1 = *(const bf16x8*)(Tt + ((32 * pr + i16) * LDP + 32 * pr + 8 * hi) * 2);
              f32x16 m1 = __builtin_amdgcn_mfma_f32_32x32x16_bf16(a1, b1, zero16(), 0, 0, 0);
#pragma unroll
              for (int g = 0; g < 4; ++g) { const int row = 8 * g + 4 * hi; u32x2 wv; wv.x = pk2(m1[4 * g], m1[4 * g + 1]); wv.y = pk2(m1[4 * g + 2], m1[4 * g + 3]); *(u32x2*)(SC + (l32 * 40 + row) * 2) = wv; }
              asm volatile("s_waitcnt lgkmcnt(0)" ::: "memory");
              const bf16x8 a2 = *(const bf16x8*)(Tn + ((32 * pr + 16 + i16) * LDP + 32 * pr + 16 + 8 * hi) * 2);
              const bf16x8 b2 = *(const bf16x8*)(SC + (l32 * 40 + 16 * pr + 8 * hi) * 2);
              f32x16 t1 = __builtin_amdgcn_mfma_f32_32x32x16_bf16(a2, b2, zero16(), 0, 0, 0);
#pragma unroll
              for (int r = 0; r < 16; ++r) { const int row = crow(r, hi); if ((row >> 4) == pr) { const unsigned short hv = f2bf(t1[r]);
                  *(unsigned short*)(Tn + ((32 * pr + 16 + (row & 15)) * LDP + 32 * pr + i16) * 2) = hv; *(unsigned short*)(Tt + ((32 * pr + i16) * LDP + 32 * pr + 16 + (row & 15)) * 2) = hv; } }
              asm volatile("s_waitcnt lgkmcnt(0)" ::: "memory"); }
            {
              f32x16 m2 = zero16();
#pragma unroll
              for (int s = 0; s < 2; ++s) { const bf16x8 a = *(const bf16x8*)(SL(0) + ((32 + l32) * LDP + 16 * s + 8 * hi) * 2); const bf16x8 b = *(const bf16x8*)(Tt + (l32 * LDP + 16 * s + 8 * hi) * 2);
                  m2 = __builtin_amdgcn_mfma_f32_32x32x16_bf16(a, b, m2, 0, 0, 0); }
#pragma unroll
              for (int g = 0; g < 4; ++g) { const int row = 8 * g + 4 * hi; u32x2 wv; wv.x = pk2(m2[4 * g], m2[4 * g + 1]); wv.y = pk2(m2[4 * g + 2], m2[4 * g + 3]); *(u32x2*)(SC + (l32 * 40 + row) * 2) = wv; }
              asm volatile("s_waitcnt lgkmcnt(0)" ::: "memory");
              f32x16 t2 = zero16();
#pragma unroll
              for (int s = 0; s < 2; ++s) { const bf16x8 a = *(const bf16x8*)(Tn + ((32 + l32) * LDP + 32 + 16 * s + 8 * hi) * 2); const bf16x8 b = *(const bf16x8*)(SC + (l32 * 40 + 16 * s + 8 * hi) * 2);
                  t2 = __builtin_amdgcn_mfma_f32_32x32x16_bf16(a, b, t2, 0, 0, 0); }
#pragma unroll
              for (int r = 0; r < 16; ++r) *(unsigned short*)(Tn + ((32 + crow(r, hi)) * LDP + l32) * 2) = f2bf(t2[r]); }
        }
        __syncthreads();
        { bf16x8 fa[4], fb[4];
          if (w < 4) { ldf(SL(3), m0, lane, fa); ldf(SL(4), n0, lane, fb); } else { ldf(SL(8), m0, lane, fa); ldf(SL(5), n0, lane, fb); }
          __syncthreads();
          f32x16 acc = zero16(); mma4(acc, fa, fb);
          st_t<0>(w < 4 ? SL(4) : SL(8), m0, n0, lane, acc);
          __syncthreads(); }
        { bf16x8 fa[4], fb[4];
          if (w < 4) { ldf(SL(3), m0, lane, fa); ldf(SL(8), n0, lane, fb); }
          __syncthreads();
          if (w < 4) { f32x16 acc = zero16(); mma4(acc, fa, fb); st_t<0>(SL(8), m0, n0, lane, acc); }
          __syncthreads(); }
        if (MODE != 1) {
            bf16x8 fa[4], fb[4]; f32x16 acc = zero16();
            if (w < 4) { ldf(SL(4), m0, lane, fa); ldf(SL(6), n0, lane, fb); mma4(acc, fa, fb);
                bf16_t* PT = (bf16_t*)(ws + WS_PT) + (size_t)ci * 4096; const int col = n0 + l32;
#pragma unroll
                for (int g = 0; g < 4; ++g) { const int row = m0 + 8 * g + 4 * hi; float o[4];
#pragma unroll
                    for (int e = 0; e < 4; ++e) o[e] = acc[4 * g + e] + ((row + e) == col ? gC[col] : 0.f);
                    u32x2 wv; wv.x = pk2(o[0], o[1]); wv.y = pk2(o[2], o[3]); *(u32x2*)(PT + col * 64 + row) = wv; }
            } else { ldf(SL(8), m0, lane, fa); ldf(SL(6), n0, lane, fb); mma4(acc, fa, fb); ldf(SL(5), m0, lane, fa); ldf(SL(7), n0, lane, fb); mma4(acc, fa, fb);
                bf16_t* LC = (bf16_t*)(ws + WS_LC) + (size_t)ci * 4096 + (q * 64 + lane) * 16; float o[16];
#pragma unroll
                for (int r = 0; r < 16; ++r) o[r] = acc[r];
                *(u32x4*)LC = pack8(o); *(u32x4*)(LC + 8) = pack8(o + 8); }
            __syncthreads();
        }
        if (MODE == 1) {
            bf16x8 fa[4], fb[4]; f32x16 acc = zero16();
            if (w < 4) { ldf(SL(9), m0, lane, fa); ldf(SL(4), n0, lane, fb);
#pragma unroll
                for (int r = 0; r < 16; ++r) acc[r] = bf2f(*(const unsigned short*)(SL(1) + ((m0 + crow(r, hi)) * LDP + n0 + l32) * 2));
                mma4(acc, fa, fb); st_n<0>(SL(1), m0, n0, lane, acc);
            } else {
                ldf(SL(9), m0, lane, fa); ldf(SL(8), n0, lane, fb); mma4(acc, fa, fb);
                ldf(SL(10), m0, lane, fa); ldf(SL(5), n0, lane, fb); mma4(acc, fa, fb);
            }
            __syncthreads();
            if (w >= 4) {
                ldf(SL(1), m0, lane, fa); ldf_g((const bf16_t*)(ws + WS_LC) + (size_t)ci * 4096, n0, lane, fb); mma4(acc, fa, fb);

                bf16_t* Yg = (bf16_t*)(ws + (dir ? WS_YB : WS_YF));
#pragma unroll
                for (int r = 0; r < 16; ++r) { const int step = 64 * c + m0 + crow(r, hi); Yg[(tb + (size_t)(dir ? (SEQ - 1 - step) : step)) * 512 + colbase + n0 + l32] = f2bf(acc[r]); } }
            __syncthreads();
        }
        if (MODE == 2) {
            bf16x8 fa[4], fb[4]; f32x16 acc = zero16();
            if (w < 4) { ldf(SL(9), m0, lane, fa); ldf(SL(4), n0, lane, fb);
#pragma unroll
                for (int r = 0; r < 16; ++r) acc[r] = bf2f(*(const unsigned short*)(SL(1) + ((m0 + crow(r, hi)) * LDP + n0 + l32) * 2));
                mma4(acc, fa, fb);
                unsigned char* RPb = ws + (dir ? WS_WBK : WS_WF);
#pragma unroll
                for (int r = 0; r < 16; ++r) { const int step = 64 * c + m0 + crow(r, hi); *(unsigned short*)(RPb + ((tb + (size_t)(dir ? (SEQ - 1 - step) : step)) * 512 + colbase) * 4 + (n0 + l32) * 2) = f2bf(acc[r]); }
            } else { ldf(SL(9), m0, lane, fa); ldf(SL(8), n0, lane, fb); mma4(acc, fa, fb); ldf(SL(10), m0, lane, fa); ldf(SL(5), n0, lane, fb); mma4(acc, fa, fb);
                bf16_t* Yg = (bf16_t*)(ws + (dir ? WS_YB : WS_YF));
#pragma unroll
                for (int r = 0; r < 16; ++r) { const int step = 64 * c + m0 + crow(r, hi); Yg[(tb + (size_t)(dir ? (SEQ - 1 - step) : step)) * 512 + colbase + n0 + l32] = f2bf(acc[r]); } }
            __syncthreads();
        }
    }
#undef SL
}

__device__ void chunk_out_pass(unsigned char* ws) {
    const int tid = tid_opaque(), w = __builtin_amdgcn_readfirstlane(tid >> 6), lane = tid & 63, hi = lane >> 5, l32 = lane & 31;
    const int q = w & 3, m0 = (q >> 1) * 32, n0 = (q & 1) * 32, half = w >> 2;
    for (int ci = bid_opaque() * 2 + half; ci < 4096; ci += 2 * (int)gridDim.x) {
        const int inst = ci >> 7, c = ci & 127, b = inst >> 4, h = (inst >> 1) & 7, dir = inst & 1;
        const size_t tb = (size_t)b * SEQ; const int colbase = h * 64;
        const unsigned char* RPb = ws + (dir ? WS_WBK : WS_WF); bf16_t* Yg = (bf16_t*)(ws + (dir ? WS_YB : WS_YF));
        bf16x8 fa[4], fb[4]; f32x16 acc;
        { const int step = 64 * c + m0 + l32; const unsigned char* p = RPb + ((tb + (size_t)(dir ? (SEQ - 1 - step) : step)) * 512 + colbase) * 4 + 16 * hi;
#pragma unroll
          for (int s = 0; s < 4; ++s) fa[s] = *(const bf16x8*)(p + 32 * s); }
        ldf_g((const bf16_t*)(ws + WS_LC) + (size_t)ci * 4096, n0, lane, fb);
#pragma unroll
        for (int r = 0; r < 16; ++r) { const int step = 64 * c + m0 + crow(r, hi); acc[r] = bf2f(Yg[(tb + (size_t)(dir ? (SEQ - 1 - step) : step)) * 512 + colbase + n0 + l32]); }
        mma4(acc, fa, fb);
#pragma unroll
        for (int r = 0; r < 16; ++r) { const int step = 64 * c + m0 + crow(r, hi); Yg[(tb + (size_t)(dir ? (SEQ - 1 - step) : step)) * 512 + colbase + n0 + l32] = f2bf(acc[r]); }
    }
}
__device__ void chain_pass(unsigned char* lds, unsigned char* ws, int inst) {
    const int tid = tid_opaque(), w = __builtin_amdgcn_readfirstlane(tid >> 6), lane = tid & 63, hi = lane >> 5, l32 = lane & 31;
    const int q = w & 3, m0 = (q >> 1) * 32, n0 = (q & 1) * 32;
    unsigned char* Shi = lds; unsigned char* Slo = lds + SLOT;
    f32x16 S = zero16();
    bf16x8 fpA[4], fpB[4]; u32x4 lcA0 = (u32x4){0u, 0u, 0u, 0u}, lcA1 = lcA0, lcB0 = lcA0, lcB1 = lcA0;
    const bf16_t* PTb = (const bf16_t*)(ws + WS_PT) + (size_t)inst * 128 * 4096; bf16_t* LCb = (bf16_t*)(ws + WS_LC) + (size_t)inst * 128 * 4096;
#define CH_PREF(FP, L0, L1, cc) do { ldf_g(PTb + (size_t)(cc) * 4096, n0, lane, FP); const bf16_t* LC_ = LCb + (size_t)(cc) * 4096 + (q * 64 + lane) * 16; L0 = *(const u32x4*)LC_; L1 = *(const u32x4*)(LC_ + 8); } while (0)
#define CH_STEP(FP, L0, L1, FPN, LN0, LN1, cc) do { \
        if (w < 4) { const int col = n0 + l32; \
            _Pragma("unroll") for (int r = 0; r < 16; ++r) { const int row = m0 + crow(r, hi); const unsigned short hb = f2bf(S[r]); const float lo = S[r] - bf2f(hb); \
                *(unsigned short*)(Shi + (row * LDP + col) * 2) = hb; *(unsigned short*)(Slo + (row * LDP + col) * 2) = f2bf(lo); } \
            asm volatile("s_waitcnt vmcnt(0)" ::: "memory");     } \
        __syncthreads(); \
        if (w >= 4) { bf16_t* S0 = LCb + (size_t)(cc) * 4096; const int t2 = tid - 256; \
            _Pragma("unroll") for (int e = 0; e < 2; ++e) { const int idx = t2 + 256 * e, row = idx >> 3, kc = (idx & 7) * 8; *(u32x4*)(S0 + row * 64 + kc) = *(const u32x4*)(Shi + (row * LDP + kc) * 2); } \
        } else { \
            if ((cc) + 1 < 128) CH_PREF(FPN, LN0, LN1, (cc) + 1); \
            bf16x8 fa[4], fl[4]; f32x16 acc, acc2 = zero16(); float lcv[16]; unpack8(L0, lcv); unpack8(L1, lcv + 8); \
            _Pragma("unroll") for (int r = 0; r < 16; ++r) acc[r] = lcv[r]; \
            ldf(Shi, m0, lane, fa); ldf(Slo, m0, lane, fl); \
            _Pragma("unroll") for (int s = 0; s < 4; ++s) { acc = __builtin_amdgcn_mfma_f32_32x32x16_bf16(fa[s], FP[s], acc, 0, 0, 0); acc2 = __builtin_amdgcn_mfma_f32_32x32x16_bf16(fl[s], FP[s], acc2, 0, 0, 0); } \
            S = acc + acc2; } \
        __syncthreads(); } while (0)
    if (w < 4) CH_PREF(fpA, lcA0, lcA1, 0);
    __syncthreads();
    for (int c = 0; c < 128; c += 2) {
        CH_STEP(fpA, lcA0, lcA1, fpB, lcB0, lcB1, c);
        CH_STEP(fpB, lcB0, lcB1, fpA, lcA0, lcA1, c + 1);
    }
#undef CH_PREF
#undef CH_STEP
}
}
namespace att {
constexpr int NW = 8, QBLK = 32, KVBLK = 64, LDQ = 1536;
constexpr float THR = 8.0f;
constexpr size_t SHM_V = KVBLK * 128 * 2, SHM_K = KVBLK * 64 * 2, SHM_ATTN = 2 * SHM_V + 2 * SHM_K + NW * 64 * 4;
#define KSWZ(row, colB) ((row) * 128 + ((colB) ^ (((row) & 7) << 4)))
#define SBAR() __builtin_amdgcn_sched_barrier(0)
__device__ __forceinline__ int crow(int r, int hi) { return (r & 3) + 8 * (r >> 2) + 4 * hi; }
__device__ __forceinline__ unsigned cvtpk(float lo, float hi) { unsigned r; asm volatile("v_cvt_pk_bf16_f32 %0, %1, %2" : "=v"(r) : "v"(lo), "v"(hi)); return r; }
__device__ __forceinline__ void partialSM(f32x16& p0, f32x16& p1, float& m_reg, float& mn, float& alpha, float dq, float slope2, int hi) {
    const float d0 = dq - (float)(4 * hi);
#pragma unroll
    for (int r = 0; r < 16; ++r) { const float c = (float)((r & 3) + 8 * (r >> 2)); p0[r] = fmaf(-slope2, fabsf(d0 - c), p0[r]); p1[r] = fmaf(-slope2, fabsf(d0 - c - 32.0f), p1[r]); }
    float pmax = p0[0];
#pragma unroll
    for (int r = 1; r < 16; ++r) pmax = fmaxf(pmax, p0[r]);
#pragma unroll
    for (int r = 0; r < 16; ++r) pmax = fmaxf(pmax, p1[r]);
    { auto rr = __builtin_amdgcn_permlane32_swap(__float_as_uint(pmax), __float_as_uint(pmax), false, false); pmax = fmaxf(__uint_as_float(rr[0]), __uint_as_float(rr[1])); }
    if (__builtin_expect(__all(pmax - m_reg <= THR), 1)) { mn = m_reg; alpha = 1.f; }
    else { mn = fmaxf(m_reg, pmax); alpha = __builtin_amdgcn_exp2f(m_reg - mn); m_reg = mn; }
#pragma unroll
    for (int r = 0; r < 16; ++r) { p0[r] = p0[r] - mn; p1[r] = p1[r] - mn; }
#pragma unroll
    for (int r = 0; r < 16; ++r) p0[r] = __builtin_amdgcn_exp2f(p0[r]);
}
__device__ __forceinline__ void finishSM(f32x16& p0, f32x16& p1, float alpha, float& l_reg, bf16x8& pa0, bf16x8& pa1, bf16x8& pa2, bf16x8& pa3) {
#pragma unroll
    for (int r = 0; r < 16; ++r) p1[r] = __builtin_amdgcn_exp2f(p1[r]);
    float ps = 0;
#pragma unroll
    for (int r = 0; r < 16; ++r) ps += p0[r];
#pragma unroll
    for (int r = 0; r < 16; ++r) ps += p1[r];
    { auto rr = __builtin_amdgcn_permlane32_swap(__float_as_uint(ps), __float_as_uint(ps), false, false); ps = __uint_as_float(rr[0]) + __uint_as_float(rr[1]); }
    l_reg = l_reg * alpha + ps;
#define PK4(P, BASE, OUT) do { unsigned a0 = cvtpk(P[BASE + 0], P[BASE + 1]), a1 = cvtpk(P[BASE + 2], P[BASE + 3]);   \
    unsigned b0 = cvtpk(P[BASE + 4], P[BASE + 5]), b1 = cvtpk(P[BASE + 6], P[BASE + 7]);                              \
    auto r0 = __builtin_amdgcn_permlane32_swap(a0, b0, false, false); auto r1 = __builtin_amdgcn_permlane32_swap(a1, b1, false, false); \
    u32x4 w = {r0[0], r1[0], r0[1], r1[1]}; OUT = *reinterpret_cast<bf16x8*>(&w); } while (0)
    PK4(p0, 0, pa0); PK4(p0, 8, pa1); PK4(p1, 0, pa2); PK4(p1, 8, pa3);
#undef PK4
}
__device__ __forceinline__ void qkt(f32x16& p0, f32x16& p1, const char* Ks, const bf16x8* qr, int r32, int hi) {
    p0 = f32x16{}; p1 = f32x16{};
#pragma unroll
    for (int d0 = 0; d0 < 4; ++d0) { const int cb = (d0 * 16 + hi * 8) * 2;
        const bf16x8 b0 = *reinterpret_cast<const bf16x8*>(Ks + KSWZ(r32, cb));
        const bf16x8 b1 = *reinterpret_cast<const bf16x8*>(Ks + KSWZ(32 + r32, cb));
        p0 = __builtin_amdgcn_mfma_f32_32x32x16_bf16(b0, qr[d0], p0, 0, 0, 0);
        p1 = __builtin_amdgcn_mfma_f32_32x32x16_bf16(b1, qr[d0], p1, 0, 0, 0); }
}
__device__ __forceinline__ int v_st(int k, int c) { const int kk = (k & ~0xC) | ((k & 4) << 1) | ((k & 8) >> 1); return ((kk >> 3) * 4 + (c >> 5)) * 512 + ((kk & 7) * 32 + (c & 31)) * 2; }
__device__ __forceinline__ int v_rd_base(int lane) { return ((lane & 3) << 3) | (((lane >> 2) & 3) << 6) | (((lane >> 4) & 1) << 5) | (((lane >> 5) & 1) << 8); }
constexpr int v_rd_off(int d0, int ks, int half) { return d0 * 512 + ks * 4096 + half * 2048; }
template <int OFF> __device__ __forceinline__ s16x4 tr_read(int vb) { s16x4 r; asm volatile("ds_read_b64_tr_b16 %0, %1 offset:%2" : "=&v"(r) : "v"(vb), "i"(OFF) : "memory"); return r; }
template <int D0> __device__ __forceinline__ void pv_one(f32x16& od, int vb, bf16x8 pa0, bf16x8 pa1, bf16x8 pa2, bf16x8 pa3) {
    const s16x4 l0 = tr_read<v_rd_off(D0, 0, 0)>(vb), h0 = tr_read<v_rd_off(D0, 0, 1)>(vb), l1 = tr_read<v_rd_off(D0, 1, 0)>(vb), h1 = tr_read<v_rd_off(D0, 1, 1)>(vb);
    const s16x4 l2 = tr_read<v_rd_off(D0, 2, 0)>(vb), h2 = tr_read<v_rd_off(D0, 2, 1)>(vb), l3 = tr_read<v_rd_off(D0, 3, 0)>(vb), h3 = tr_read<v_rd_off(D0, 3, 1)>(vb);
    asm volatile("s_waitcnt lgkmcnt(0)" ::: "memory"); SBAR();
#define PK(L, H) (bf16x8){L[0], L[1], L[2], L[3], H[0], H[1], H[2], H[3]}
    od = __builtin_amdgcn_mfma_f32_32x32x16_bf16(pa0, PK(l0, h0), od, 0, 0, 0);
    od = __builtin_amdgcn_mfma_f32_32x32x16_bf16(pa1, PK(l1, h1), od, 0, 0, 0);
    od = __builtin_amdgcn_mfma_f32_32x32x16_bf16(pa2, PK(l2, h2), od, 0, 0, 0);
    od = __builtin_amdgcn_mfma_f32_32x32x16_bf16(pa3, PK(l3, h3), od, 0, 0, 0);
#undef PK
}
__device__ __forceinline__ void pv_d0(f32x16* o, int vb, bf16x8 pa0, bf16x8 pa1, bf16x8 pa2, bf16x8 pa3) {
    pv_one<0>(o[0], vb, pa0, pa1, pa2, pa3); pv_one<1>(o[1], vb, pa0, pa1, pa2, pa3); pv_one<2>(o[2], vb, pa0, pa1, pa2, pa3); pv_one<3>(o[3], vb, pa0, pa1, pa2, pa3);
}
__device__ __forceinline__ void attn_unit(const bf16_t* __restrict__ Qb, const bf16_t* __restrict__ Kh, const bf16_t* __restrict__ Vh, bf16_t* __restrict__ Ob, int qpos0, float slope2, char* lds, const int NT) {
    const int tid = tid_opaque(), wid = tid >> 6, lane = tid & 63, r32 = lane & 31, hi = lane >> 5;
    char* V_lds = lds; char* K_lds = lds + 2 * SHM_V;
    float* wsf = (float*)(lds + 2 * SHM_V + 2 * SHM_K) + wid * 64; float* li_l = wsf; float* al_l = wsf + 32;
    float m_reg = -1e30f, l_reg = 0; f32x16 o[4] = {}; bf16x8 qr[4];
    const bf16_t* Qw = Qb + (size_t)(wid * QBLK + r32) * LDQ + hi * 8;
#pragma unroll
    for (int d0 = 0; d0 < 4; ++d0) qr[d0] = *reinterpret_cast<const bf16x8*>(Qw + d0 * 16);
    const float qposf = (float)(qpos0 + wid * QBLK + r32);
    const int sr = tid >> 4, sc = (tid & 15) * 8, vst0 = v_st(sr, sc), vst1 = v_st(32 + sr, sc);
    const int kr = tid >> 3, kc = (tid & 7) * 8, kst = KSWZ(kr, kc * 2);
    const int vb0 = (int)(uintptr_t)V_lds + v_rd_base(lane);
    bf16x8 sv0[2], sv1[2], sk0[2];
#define SLOAD(i, k0) do { sv0[i] = *reinterpret_cast<const bf16x8*>(&Vh[(size_t)((k0) + sr) * LDQ + sc]); sv1[i] = *reinterpret_cast<const bf16x8*>(&Vh[(size_t)((k0) + 32 + sr) * LDQ + sc]); \
    sk0[i] = *reinterpret_cast<const bf16x8*>(&Kh[(size_t)((k0) + kr) * LDQ + kc]); } while (0)
#define SWRITE(b, i) do { *(bf16x8*)(V_lds + (b) * SHM_V + vst0) = sv0[i]; *(bf16x8*)(V_lds + (b) * SHM_V + vst1) = sv1[i]; *(bf16x8*)(K_lds + (b) * SHM_K + kst) = sk0[i]; } while (0)
#define SWAIT() asm volatile("s_waitcnt vmcnt(3)" ::: "memory")
#define RESC(a) do { if (__any((a) < 1.f)) { if (hi == 0) al_l[r32] = (a); asm volatile("s_waitcnt lgkmcnt(0)" ::: "memory"); \
    _Pragma("unroll") for (int d = 0; d < 4; ++d) _Pragma("unroll") for (int r = 0; r < 16; ++r) o[d][r] *= al_l[crow(r, hi)]; } } while (0)
    f32x16 pA0, pA1, pB0, pB1; float mnA, mnB, alA, alB; bf16x8 pa0, pa1, pa2, pa3;
    __syncthreads();
    SLOAD(0, 0); asm volatile("s_waitcnt vmcnt(0)" ::: "memory"); SWRITE(0, 0); __syncthreads();
    qkt(pA0, pA1, K_lds, qr, r32, hi); partialSM(pA0, pA1, m_reg, mnA, alA, qposf, slope2, hi);
    SLOAD(1, KVBLK); if (2 < NT) SLOAD(0, 2 * KVBLK);
    SWAIT(); SWRITE(1, 1); __syncthreads();
    for (int j = 1; j + 1 < NT; j += 2) {
        SBAR(); qkt(pB0, pB1, K_lds + SHM_K, qr, r32, hi);
        finishSM(pA0, pA1, alA, l_reg, pa0, pa1, pa2, pa3); SBAR();
        SLOAD(1, (j + 2) * KVBLK); SBAR();
        pv_d0(o, vb0, pa0, pa1, pa2, pa3); partialSM(pB0, pB1, m_reg, mnB, alB, qposf - (float)(j * KVBLK), slope2, hi);
        __syncthreads(); SWAIT(); SWRITE(0, 0);
        RESC(alB); __syncthreads();
        SBAR(); qkt(pA0, pA1, K_lds, qr, r32, hi);
        finishSM(pB0, pB1, alB, l_reg, pa0, pa1, pa2, pa3); SBAR();
        if (j + 3 < NT) SLOAD(0, (j + 3) * KVBLK); SBAR();
        pv_d0(o, vb0 + (int)SHM_V, pa0, pa1, pa2, pa3); partialSM(pA0, pA1, m_reg, mnA, alA, qposf - (float)((j + 1) * KVBLK), slope2, hi);
        __syncthreads(); SWAIT(); SWRITE(1, 1);
        RESC(alA); __syncthreads();
    }
    SBAR(); qkt(pB0, pB1, K_lds + SHM_K, qr, r32, hi);
    finishSM(pA0, pA1, alA, l_reg, pa0, pa1, pa2, pa3); SBAR();
    pv_d0(o, vb0, pa0, pa1, pa2, pa3); partialSM(pB0, pB1, m_reg, mnB, alB, qposf - (float)((NT - 1) * KVBLK), slope2, hi);
    __syncthreads(); RESC(alB);
    finishSM(pB0, pB1, alB, l_reg, pa0, pa1, pa2, pa3); SBAR();
    pv_d0(o, vb0 + (int)SHM_V, pa0, pa1, pa2, pa3);
    if (hi == 0) li_l[r32] = l_reg; asm volatile("s_waitcnt lgkmcnt(0)" ::: "memory");
    float rli[16];
#pragma unroll
    for (int r = 0; r < 16; ++r) rli[r] = __builtin_amdgcn_rcpf(li_l[crow(r, hi)]);
    bf16_t* Ow = Ob + (size_t)(wid * QBLK) * 512;
#pragma unroll
    for (int r = 0; r < 16; ++r) { const int orow = crow(r, hi);
#pragma unroll
        for (int d0 = 0; d0 < 4; ++d0) Ow[(size_t)orow * 512 + d0 * 32 + r32] = (bf16_t)(cvtpk(o[d0][r] * rli[r], 0.f) & 0xffffu); }
#undef SLOAD
#undef SWRITE
#undef SWAIT
#undef RESC
}
}
#define XB_TMO      128
#define XB_XCNT(j)  (256  + 64 * (j))
#define XB_XSUB(j)  (1280 + 64 * (j))
#define XB_XGEN(j)  (2304 + 64 * (j))
#define XB_TOP      3328
#define XB_TOPGEN   3392
#define XCD_BAR_WORDS 3456
#define XB_SPIN_CAP (1u << 18)

__device__ __forceinline__ unsigned xb_ld(unsigned* p)              { return __hip_atomic_load(p, __ATOMIC_RELAXED, __HIP_MEMORY_SCOPE_AGENT); }
__device__ __forceinline__ unsigned xb_add(unsigned* p, unsigned v) { return __hip_atomic_fetch_add(p, v, __ATOMIC_RELAXED, __HIP_MEMORY_SCOPE_AGENT); }
__device__ __forceinline__ unsigned xb_xcc_id() { return (unsigned)__builtin_amdgcn_s_getreg((3 << 11) | 20) & 0xFu; }
#define XB_SPIN(cond, bar) do { unsigned _sp = 0; while (cond) { __builtin_amdgcn_s_sleep(1); \
    if ((++_sp & 255u) == 0u) { if (xb_ld(&(bar)[XB_TMO])) break; if (_sp > XB_SPIN_CAP) { atomicAdd(&(bar)[XB_TMO], 1u); break; } } } } while (0)

struct XcdBarrier {
    unsigned* bar; unsigned x;
    volatile LAS unsigned* st;
};

__device__ __forceinline__ XcdBarrier xcd_barrier_post(unsigned* bar, volatile LAS unsigned* st) {
    XcdBarrier b; b.bar = bar; b.x = xb_xcc_id(); b.st = st;
    if (threadIdx.x == 0) (void)xb_add(&bar[XB_XCNT(b.x)], 1u);
    return b;
}
__device__ __forceinline__ void xcd_barrier_complete(unsigned* bar, unsigned x, unsigned& nloc, unsigned& nx) {
    const unsigned G = gridDim.x * gridDim.y * gridDim.z;
    unsigned sum, cnt, mine, sp = 0u;
    for (;;) {
        sum = 0u; cnt = 0u; mine = 0u;
#pragma unroll
        for (unsigned j = 0; j < 16; ++j) { const unsigned c = xb_ld(&bar[XB_XCNT(j)]); sum += c; cnt += (c > 0u) ? 1u : 0u; mine = (j == x) ? c : mine; }
        if (sum == G) break;
        __builtin_amdgcn_s_sleep(1);
        if ((++sp & 255u) == 0u) { if (xb_ld(&bar[XB_TMO])) break; if (sp > XB_SPIN_CAP) { atomicAdd(&bar[XB_TMO], 1u); break; } }
    }
    nloc = mine > 0u ? mine : 1u; nx = cnt > 0u ? cnt : 1u;
}

__device__ __forceinline__ void xcd_barrier(const XcdBarrier& b) {
    asm volatile("s_waitcnt vmcnt(0)" ::: "memory");
    __syncthreads();
    if (threadIdx.x == 0) {
        unsigned* bar = b.bar;
        __builtin_amdgcn_s_waitcnt(0);
        unsigned nloc = b.st[0], nx = b.st[1];
        if (nloc == 0u) { xcd_barrier_complete(bar, b.x, nloc, nx); b.st[0] = nloc; b.st[1] = nx; }
        const unsigned old = xb_add(&bar[XB_XSUB(b.x)], 1u);
        const unsigned gen = old / nloc;
        if (old + 1u == (gen + 1u) * nloc) {
            __builtin_amdgcn_fence(__ATOMIC_RELEASE, "agent");
            asm volatile("s_waitcnt vmcnt(0)" ::: "memory");
            const unsigned og = xb_add(&bar[XB_TOP], 1u);
            const unsigned tg = og / nx;
            if (og + 1u == (tg + 1u) * nx) xb_add(&bar[XB_TOPGEN], 1u);
            else XB_SPIN(xb_ld(&bar[XB_TOPGEN]) == tg, bar);
            __builtin_amdgcn_fence(__ATOMIC_ACQUIRE, "agent");
            xb_add(&bar[XB_XGEN(b.x)], 1u);
            asm volatile("s_waitcnt vmcnt(0)" ::: "memory");
        } else {
            XB_SPIN(xb_ld(&bar[XB_XGEN(b.x)]) == gen, bar);
            __builtin_amdgcn_fence(__ATOMIC_ACQUIRE, "agent");
            asm volatile("s_waitcnt vmcnt(0)" ::: "memory");
        }
    }
    __syncthreads();
}

__device__ void mixer_phase(const Params& P, int l, unsigned char* smem) {
    unsigned char* ws = P.ws;
    const int bid = bid_opaque(); const int tid0 = tid_opaque();
    if (bid < 32) ck::chain_pass(smem, ws, bid);
    unsigned* ctr = (unsigned*)(ws + WS_CTL) + 64 * l;
    volatile unsigned* slot = (volatile unsigned*)(smem + 131072);
    const bf16_t* QKV = (const bf16_t*)(ws + WS_QKV);
    float gq = fabsf(P.in[17][l * 64 + (tid0 & 63)]), gk = fabsf(P.in[18][l * 64 + (tid0 & 63)]);
#pragma unroll
    for (int o = 32; o > 0; o >>= 1) { gq = fmaxf(gq, __shfl_xor(gq, o)); gk = fmaxf(gk, __shfl_xor(gk, o)); }
    const float smax2 = 2.0f * 8.0f * LOG2E * gq * gk + 150.0f;
    for (;;) {
        __syncthreads();
        if (tid0 == 0) slot[0] = atomicAdd(ctr, 1u);
        __syncthreads();
        const unsigned u = slot[0];
        if (u >= 512u) {
            const unsigned bt = u - 512u; if (bt >= (unsigned)(CVT_FFN_TILES / 8)) break;
            for (int t8 = 0; t8 < 8; ++t8) cvt_ffn_tile(smem, ws, P.in[24] + (size_t)l * DM * NFF, P.in[25] + (size_t)l * DFF * DM, (int)bt * 8 + t8, tid0);
            continue; }
        const int qb = u & 31, rest = u >> 5, map = rest & 1, b = (rest >> 1) & 1, h = 3 - (rest >> 2);
        const size_t row0 = (size_t)b * SEQ + (size_t)qb * 256;
        const float slope2 = exp2f(-2.0f * (float)(h + 1)) * LOG2E;
        const int W = (int)fminf(smax2 / slope2, 16384.0f) + 1;
        int jlo = (qb * 256 - W) >> 6; if (jlo < 0) jlo = 0;
        int jhi = ((qb * 256 + 255 + W) >> 6) + 1; if (jhi > SEQ / 64) jhi = SEQ / 64;
        if ((jhi - jlo) & 1) { if (jlo > 0) --jlo; else ++jhi; }
        bf16_t* Ob = (bf16_t*)(ws + (map ? WS_O1 : WS_O0)) + row0 * 512 + h * 128;
        const bf16_t* Kb0 = QKV + ((size_t)b * SEQ + (size_t)jlo * 64) * 1536;
        att::attn_unit(QKV + row0 * 1536 + h * 128 + map * 64, Kb0 + 512 + h * 128 + map * 64, Kb0 + 1024 + h * 128, Ob, qb * 256 - jlo * 64, slope2, (char*)smem, jhi - jlo);
    }
}
__device__ void post_phase(const Params& P, int l) {
    unsigned char* ws = P.ws;
    const bf16_t* YF = (const bf16_t*)(ws + WS_YF); const bf16_t* YB = (const bf16_t*)(ws + WS_YB); const bf16_t* R = (const bf16_t*)(ws + WS_R); const bf16_t* V = (const bf16_t*)(ws + WS_V);
    const bf16_t* AF = (const bf16_t*)(ws + WS_AF); const bf16_t* AB = (const bf16_t*)(ws + WS_AB); const bf16_t* Kb = (const bf16_t*)(ws + WS_K); const float* k_a = P.in[13] + l * 512; const bf16_t* GATE = (const bf16_t*)(ws + WS_GATE);
    const bf16_t* O0 = (const bf16_t*)(ws + WS_O0); const bf16_t* O1 = (const bf16_t*)(ws + WS_O1); bf16_t* AO = (bf16_t*)(ws + WS_AO);
    const float* r_k = P.in[14] + l * 512; const float* lng = P.in[15] + l * 512; const float* lnb = P.in[16] + l * 512; const float* lamv = P.in[19] + l * 256; const float* subg = P.in[20] + l * 128;
    const int tid_ = tid_opaque(); const int lane = tid_ & 63, gw = bid_opaque() * 8 + (tid_ >> 6), nw = gridDim.x * 8;
    const float lam_init = 0.8f - 0.6f * expf(-0.3f * (float)l);
    const float s1 = wave_sum(lamv[lane] * lamv[64 + lane]), s2 = wave_sum(lamv[128 + lane] * lamv[192 + lane]);
    const float lam = expf(s1) - expf(s2) + lam_init;
    const int c0 = 8 * lane;
    const f32x4 ka0 = *(const f32x4*)(k_a + c0), ka1 = *(const f32x4*)(k_a + c0 + 4); const f32x4 rk0 = *(const f32x4*)(r_k + c0), rk1 = *(const f32x4*)(r_k + c0 + 4), lg0 = *(const f32x4*)(lng + c0), lg1 = *(const f32x4*)(lng + c0 + 4), lb0 = *(const f32x4*)(lnb + c0), lb1 = *(const f32x4*)(lnb + c0 + 4);
    const f32x4 sg0 = *(const f32x4*)(subg + (c0 & 127)), sg1 = *(const f32x4*)(subg + (c0 & 127) + 4);
    for (int tok = gw; tok < T; tok += nw) {
        const size_t off = (size_t)tok * 512 + c0;
        float yf[8], yb[8], r[8], v[8], kf[8], kb[8], kx[8], gt[8], y[8], o[8];
        unpack8(*(const u32x4*)(YF + off), yf); unpack8(*(const u32x4*)(YB + off), yb); unpack8(*(const u32x4*)(R + off), r); unpack8(*(const u32x4*)(V + off), v);
        unpack8(*(const u32x4*)(AF + off), kf); unpack8(*(const u32x4*)(AB + off), kb); unpack8(*(const u32x4*)(Kb + off), kx); unpack8(*(const u32x4*)(GATE + off), gt);
        float sm = 0.f, bs = 0.f;
#pragma unroll
        for (int j = 0; j < 8; ++j) { y[j] = yf[j] + yb[j]; sm += y[j]; bs += r[j] * kx[j] * (2.0f + (kf[j] + kb[j] - 2.0f) * (j < 4 ? ka0[j] : ka1[j - 4])) * (j < 4 ? rk0[j] : rk1[j - 4]); }
        sm += __shfl_xor(sm, 1); sm += __shfl_xor(sm, 2); sm += __shfl_xor(sm, 4); bs += __shfl_xor(bs, 1); bs += __shfl_xor(bs, 2); bs += __shfl_xor(bs, 4);
        const float mean = sm * (1.0f / 64.0f); float vs = 0.f;
#pragma unroll
        for (int j = 0; j < 8; ++j) { const float d = y[j] - mean; vs += d * d; }
        vs += __shfl_xor(vs, 1); vs += __shfl_xor(vs, 2); vs += __shfl_xor(vs, 4);
        const float rstd = rsqrtf(vs * (1.0f / 64.0f) + 64e-5f);
#pragma unroll
        for (int j = 0; j < 8; ++j) { const float g = j < 4 ? lg0[j] : lg1[j - 4], bb = j < 4 ? lb0[j] : lb1[j - 4]; o[j] = ((y[j] - mean) * rstd * g + bb + bs * v[j]) * gt[j]; }
        *(u32x4*)(AO + (size_t)tok * 1024 + c0) = pack8(o);
        float a0[8], a1[8], d[8]; unpack8(*(const u32x4*)(O0 + off), a0); unpack8(*(const u32x4*)(O1 + off), a1);
        float sq = 0.f;
#pragma unroll
        for (int j = 0; j < 8; ++j) { d[j] = a0[j] - lam * a1[j]; sq += d[j] * d[j]; }
        sq += __shfl_xor(sq, 1); sq += __shfl_xor(sq, 2); sq += __shfl_xor(sq, 4); sq += __shfl_xor(sq, 8);
        const float rs = rsqrtf(sq * (1.0f / 128.0f) + 1e-6f) * (1.0f - lam_init);
#pragma unroll
        for (int j = 0; j < 8; ++j) d[j] *= rs * (j < 4 ? sg0[j] : sg1[j - 4]);
        *(u32x4*)(AO + (size_t)tok * 1024 + 512 + c0) = pack8(d);
    }
}
__device__ void outpost_phase(const Params& P, int l, unsigned char* smem) {
    unsigned char* ws = P.ws;
    const bf16_t* YF = (const bf16_t*)(ws + WS_YF); const bf16_t* YB = (const bf16_t*)(ws + WS_YB); const bf16_t* R = (const bf16_t*)(ws + WS_R); const bf16_t* V = (const bf16_t*)(ws + WS_V);
    const bf16_t* AF = (const bf16_t*)(ws + WS_AF); const bf16_t* AB = (const bf16_t*)(ws + WS_AB); const bf16_t* Kb = (const bf16_t*)(ws + WS_K); const float* k_a = P.in[13] + l * 512; const bf16_t* GATE = (const bf16_t*)(ws + WS_GATE);
    const bf16_t* O0 = (const bf16_t*)(ws + WS_O0); const bf16_t* O1 = (const bf16_t*)(ws + WS_O1); bf16_t* AO = (bf16_t*)(ws + WS_AO);
    const float* r_k = P.in[14] + l * 512; const float* lng = P.in[15] + l * 512; const float* lnb = P.in[16] + l * 512; const float* lamv = P.in[19] + l * 256; const float* subg = P.in[20] + l * 128;
    const int tid_ = tid_opaque(); const int lane = tid_ & 63, w = __builtin_amdgcn_readfirstlane(tid_ >> 6), hi = lane >> 5, l32 = lane & 31;
    float* Yb = (float*)smem;
    const float lam_init = 0.8f - 0.6f * expf(-0.3f * (float)l);
    const float s1 = wave_sum(lamv[lane] * lamv[64 + lane]), s2 = wave_sum(lamv[128 + lane] * lamv[192 + lane]);
    const float lam = expf(s1) - expf(s2) + lam_init;
    const int c0 = 8 * lane;
    const f32x4 ka0 = *(const f32x4*)(k_a + c0), ka1 = *(const f32x4*)(k_a + c0 + 4); const f32x4 rk0 = *(const f32x4*)(r_k + c0), rk1 = *(const f32x4*)(r_k + c0 + 4), lg0 = *(const f32x4*)(lng + c0), lg1 = *(const f32x4*)(lng + c0 + 4), lb0 = *(const f32x4*)(lnb + c0), lb1 = *(const f32x4*)(lnb + c0 + 4);
    const f32x4 sg0 = *(const f32x4*)(subg + (c0 & 127)), sg1 = *(const f32x4*)(subg + (c0 & 127) + 4);
    for (int blk = bid_opaque(); blk < 2 * (SEQ / 64); blk += (int)gridDim.x) {
      const int b = blk >> 7, tbk = blk & 127; const size_t tok0 = (size_t)b * SEQ + 64 * tbk;
      { const int h = w; const size_t cif = (size_t)(((b * 16 + h * 2) << 7) + tbk), cib = (size_t)(((b * 16 + h * 2 + 1) << 7) + (127 - tbk));
        const bf16_t* LCp = (const bf16_t*)(ws + WS_LC);
#pragma unroll 2
        for (int q = 0; q < 4; ++q) { const int m0 = (q >> 1) * 32, n0 = (q & 1) * 32; f32x16 acc; bf16x8 fa[4], fb[4];
#pragma unroll
            for (int r = 0; r < 16; ++r) { const size_t yo = (tok0 + m0 + ck::crow(r, hi)) * 512 + h * 64 + n0 + l32; acc[r] = bf2f(YF[yo]) + bf2f(YB[yo]); }
            { const unsigned char* p = ws + WS_WF + ((tok0 + m0 + l32) * 512 + h * 64) * 4 + 16 * hi;
#pragma unroll
              for (int s = 0; s < 4; ++s) fa[s] = *(const bf16x8*)(p + 32 * s); }
            ck::ldf_g(LCp + cif * 4096, n0, lane, fb); ck::mma4(acc, fa, fb);
            { const unsigned char* p = ws + WS_WBK + ((tok0 + m0 + l32) * 512 + h * 64) * 4 + 16 * hi;
#pragma unroll
              for (int s = 0; s < 4; ++s) fa[s] = *(const bf16x8*)(p + 32 * s); }
            ck::ldf_g(LCp + cib * 4096, n0, lane, fb); ck::mma4(acc, fa, fb);
#pragma unroll
            for (int r = 0; r < 16; ++r) Yb[(m0 + ck::crow(r, hi)) * 512 + h * 64 + n0 + l32] = acc[r]; } }
      __syncthreads();
#pragma unroll 2
      for (int ti = 0; ti < 8; ++ti) {
        const int tl = 8 * w + ti; const int tok = (int)tok0 + tl;
        const size_t off = (size_t)tok * 512 + c0;
        float r[8], v[8], kf[8], kb[8], kx[8], gt[8], y[8], o[8];
        { const f32x4 y0 = *(const f32x4*)(Yb + tl * 512 + c0), y1 = *(const f32x4*)(Yb + tl * 512 + c0 + 4); y[0] = y0[0]; y[1] = y0[1]; y[2] = y0[2]; y[3] = y0[3]; y[4] = y1[0]; y[5] = y1[1]; y[6] = y1[2]; y[7] = y1[3]; }
        unpack8(*(const u32x4*)(R + off), r); unpack8(*(const u32x4*)(V + off), v);
        unpack8(*(const u32x4*)(AF + off), kf); unpack8(*(const u32x4*)(AB + off), kb); unpack8(*(const u32x4*)(Kb + off), kx); unpack8(*(const u32x4*)(GATE + off), gt);
        float sm = 0.f, bs = 0.f;
#pragma unroll
        for (int j = 0; j < 8; ++j) { sm += y[j]; bs += r[j] * kx[j] * (2.0f + (kf[j] + kb[j] - 2.0f) * (j < 4 ? ka0[j] : ka1[j - 4])) * (j < 4 ? rk0[j] : rk1[j - 4]); }
        sm += __shfl_xor(sm, 1); sm += __shfl_xor(sm, 2); sm += __shfl_xor(sm, 4); bs += __shfl_xor(bs, 1); bs += __shfl_xor(bs, 2); bs += __shfl_xor(bs, 4);
        const float mean = sm * (1.0f / 64.0f); float vs = 0.f;
#pragma unroll
        for (int j = 0; j < 8; ++j) { const float d = y[j] - mean; vs += d * d; }
        vs += __shfl_xor(vs, 1); vs += __shfl_xor(vs, 2); vs += __shfl_xor(vs, 4);
        const float rstd = rsqrtf(vs * (1.0f / 64.0f) + 64e-5f);
#pragma unroll
        for (int j = 0; j < 8; ++j) { const float g = j < 4 ? lg0[j] : lg1[j - 4], bb = j < 4 ? lb0[j] : lb1[j - 4]; o[j] = ((y[j] - mean) * rstd * g + bb + bs * v[j]) * gt[j]; }
        *(u32x4*)(AO + (size_t)tok * 1024 + c0) = pack8(o);
        float a0[8], a1[8], d[8]; unpack8(*(const u32x4*)(O0 + off), a0); unpack8(*(const u32x4*)(O1 + off), a1);
        float sq = 0.f;
#pragma unroll
        for (int j = 0; j < 8; ++j) { d[j] = a0[j] - lam * a1[j]; sq += d[j] * d[j]; }
        sq += __shfl_xor(sq, 1); sq += __shfl_xor(sq, 2); sq += __shfl_xor(sq, 4); sq += __shfl_xor(sq, 8);
        const float rs = rsqrtf(sq * (1.0f / 128.0f) + 1e-6f) * (1.0f - lam_init);
#pragma unroll
        for (int j = 0; j < 8; ++j) d[j] *= rs * (j < 4 ? sg0[j] : sg1[j - 4]);
        *(u32x4*)(AO + (size_t)tok * 1024 + 512 + c0) = pack8(d);
      }
      __syncthreads();
    }
}
template <class Epi> __device__ __forceinline__ void run_gemm(unsigned char* smem, const bf16_t* A, const bf16_t* Bt, int N, int K, const Epi& E) {
    asm volatile("" : "+s"(K)); asm volatile("" : "+s"(N));
    pg8::Gemm g{A, Bt, T, N, K}; pg8::StaticOrder S; S.init(T, N, (int)gridDim.x, bid_opaque());
    pg8::gemm_phase<Epi, pg8::StaticOrder, true, true>((PG8_LAS unsigned char*)smem, g, S, E);
}
__global__ void __launch_bounds__(512, 2) mega_fwd(Params P) {
    extern __shared__ __attribute__((aligned(16))) unsigned char smem[];
    cg::grid_group grid = cg::this_grid();
    unsigned char* ws = P.ws;
    unsigned* barw = (unsigned*)(ws + WS_CTL) + 4096;
    volatile LAS unsigned* bst = (volatile LAS unsigned*)((LAS unsigned char*)smem + 131072 + 64);
    if (threadIdx.x < 2) bst[threadIdx.x] = 0u;
    if (P.ph_lo == 0 && blockIdx.x == 0) { if (threadIdx.x < DEPTH) ((unsigned*)(ws + WS_CTL))[64 * threadIdx.x] = 0u; for (int i = threadIdx.x; i < XCD_BAR_WORDS; i += 512) barw[i] = 0u; }
    __syncthreads();
    XcdBarrier xb; xb.bar = barw; xb.x = 0; xb.st = bst; bool posted = false;
    bf16_t* XN = (bf16_t*)(ws + WS_XN); bf16_t* H = (bf16_t*)(ws + WS_H); bf16_t* WA = (bf16_t*)(ws + WS_WA); bf16_t* WB = (bf16_t*)(ws + WS_WB);
    for (int ph = P.ph_lo; ph < P.ph_hi; ++ph) {
        const int l = ph / NPH, k = ph - l * NPH;
        const float* xcur = (l == 0 && k <= 2) ? P.in[0] : P.out;
#ifndef ONLY_K
#define ONLY_K -1
#endif
#ifndef REP_MASK
#define REP_MASK 0
#endif
        for (int rep = 0; rep < (((REP_MASK >> k) & 1) ? 2 : 1); ++rep)
        switch (ONLY_K >= 0 ? ONLY_K : k) {
        case 0: cvt_ffn(smem, ws, P.in[2] + (size_t)l * DM * NFF, P.in[3] + (size_t)l * DFF * DM); norm_rows(xcur, P.in[1] + l * DM, XN); break;
        case 1: case 13: { EpiSwiGLU E{H}; run_gemm(smem, XN, WA, NFF, DM, E); } break;
        case 2: { EpiResid E{xcur, P.out, 0.5f}; run_gemm(smem, H, WB, DM, DFF, E); } break;
        case 3: cvt_mixer(smem, ws, P.in[5] + (size_t)l * DM * CIN_SRC, P.in[8] + (size_t)l * 2 * 64 * 512, P.in[10] + (size_t)l * 2 * 64 * 512, P.in[11] + (size_t)l * 128 * 512,
                          P.in[21] + (size_t)l * 2 * 512 * DM, P.in[22] + (size_t)l * DM * DM);
                norm_rows(P.out, P.in[4] + l * DM, XN); break;
        case 4: { EpiWin E{(bf16_t*)(ws + WS_PR), (bf16_t*)(ws + WS_QKV), (bf16_t*)(ws + WS_G)}; run_gemm(smem, XN, WA, NWIN, DM, E); } break;
        case 5: prep_phase(P, l); break;
        case 6: { EpiDecay E1{P.in[7] + l * 1024, (float*)(ws + WS_WF), (float*)(ws + WS_WBK)}; run_gemm(smem, (const bf16_t*)(ws + WS_LIN), (const bf16_t*)(ws + WS_WL), 1024, KLORA, E1);
                  EpiIclr E2{P.in[9] + l * 1024, (bf16_t*)(ws + WS_AF), (bf16_t*)(ws + WS_AB), (bf16_t*)(ws + WS_GATE)}; run_gemm(smem, (const bf16_t*)(ws + WS_LIN), (const bf16_t*)(ws + WS_WL) + (size_t)1024 * KLORA, 1536, KLORA, E2); } break;
        case 7: ck::chunk_pass<2>(smem, ws, P.in[13] + l * 512); break;
        case 8: mixer_phase(P, l, smem); break;
        case 9: outpost_phase(P, l, smem); break;
        case 10: { EpiBranch E{(const bf16_t*)(ws + WS_G), XN}; run_gemm(smem, (const bf16_t*)(ws + WS_AO), (const bf16_t*)(ws + WS_WR), 2048, DM, E); } break;
        case 11: { EpiResid E{P.out, P.out, 1.0f}; run_gemm(smem, XN, (const bf16_t*)(ws + WS_WO), DM, DM, E); } break;
        case 12: norm_rows(P.out, P.in[23] + l * DM, XN); break;
        case 14: { EpiResid E{P.out, P.out, 0.5f}; run_gemm(smem, H, WB, DM, DFF, E); } break;
        default: break;
        }
        if (ph + 1 < P.ph_hi) {
            if (!posted) { grid.sync(); xb = xcd_barrier_post(barw, bst); posted = true; }
            else xcd_barrier(xb);
        }
    }
}
#ifndef MK_PER_PHASE
#define MK_PER_PHASE 0
#endif
extern "C" void kernel_launch(void* const* d_in, const int* in_sizes, int n_in, void* d_out, int out_size, void* d_ws, size_t ws_size, hipStream_t stream) {
    static int grid = 0;
    if (grid == 0) {
        if (n_in != 26 || out_size != T * DM || ws_size < WS_END) { fprintf(stderr, "kernel_launch: unexpected shapes: n_in %d out %d ws %zu (need %zu)\n", n_in, out_size, ws_size, (size_t)WS_END); grid = -1; return; }
        int dev = 0, cus = 0, per_cu = 0;
        hipGetDevice(&dev); hipDeviceGetAttribute(&cus, hipDeviceAttributeMultiprocessorCount, dev);
        if (hipFuncSetAttribute((const void*)mega_fwd, hipFuncAttributeMaxDynamicSharedMemorySize, LDS_BYTES) != hipSuccess) { fprintf(stderr, "kernel_launch: hipFuncSetAttribute failed\n"); grid = -1; return; }
        if (hipOccupancyMaxActiveBlocksPerMultiprocessor(&per_cu, (const void*)mega_fwd, 512, LDS_BYTES) != hipSuccess || per_cu < 1) { fprintf(stderr, "kernel_launch: occupancy query failed (%d)\n", per_cu); (void)hipGetLastError(); per_cu = 1; }
        grid = cus * 1;
        if (grid < 64) { fprintf(stderr, "kernel_launch: grid %d too small\n", grid); grid = -1; return; }
    }
    if (grid < 0) return;
    Params p{};
    for (int i = 0; i < 26; ++i) p.in[i] = (const float*)d_in[i];
    p.out = (float*)d_out; p.ws = (unsigned char*)d_ws;
#if MK_PER_PHASE
    for (int ph = 0; ph < NPH * DEPTH; ++ph) { p.ph_lo = ph; p.ph_hi = ph + 1; void* args[] = {&p};
        hipError_t e = hipLaunchCooperativeKernel((void*)mega_fwd, dim3(grid), dim3(512), args, LDS_BYTES, stream);
        if (e != hipSuccess) { fprintf(stderr, "launch %d failed: %s\n", ph, hipGetErrorString(e)); break; } }
#else
    p.ph_lo = 0; p.ph_hi = NPH * DEPTH; void* args[] = {&p};
    hipError_t e = hipLaunchCooperativeKernel((void*)mega_fwd, dim3(grid), dim3(512), args, LDS_BYTES, stream);
    if (e != hipSuccess) fprintf(stderr, "cooperative launch failed: %s (grid %d)\n", hipGetErrorString(e), grid);
#endif
}
```

```cpp
#include <hip/hip_runtime.h>
#include <hip/hip_cooperative_groups.h>
#include <cstdio>
#include <cstdint>
namespace cg = cooperative_groups;
__device__ __forceinline__ int tid_opaque() { int t = (int)threadIdx.x; asm volatile("" : "+v"(t)); return t; }
__device__ __forceinline__ int bid_opaque() { int t = (int)blockIdx.x; asm volatile("" : "+s"(t)); return t; }
namespace pg8 {
#define PG8_LAS __attribute__((address_space(3)))
typedef unsigned short bf16_t;
typedef short bf16x8 __attribute__((ext_vector_type(8)));
typedef float f32x4 __attribute__((ext_vector_type(4)));
typedef unsigned u32x4 __attribute__((ext_vector_type(4)));
constexpr int BM = 256, BK = 64, HALF = 128, HTB = HALF * BK * 2  , STAGE_BYTES = 8 * HTB, NXCD = 8, WGM = 8;

__host__ __device__ __forceinline__ int lds_byte(int r, int c) { const int st = (r >> 4) * 2 + (c >> 5), rr = r & 15, cc = c & 31, ob = rr * 64 + cc * 2; return st * 1024 + (ob ^ (((ob >> 9) & 1) << 5)); }
__host__ __device__ __forceinline__ void stage_rc(int b, int& R, int& C) { const int st = b / 1024, sb = b % 1024, swz = sb ^ (((sb >> 9) & 1) << 5); R = (st >> 1) * 16 + swz / 64; C = (st & 1) * 32 + (swz % 64) / 2; }
__host__ __device__ __forceinline__ int perm32(int rho) { const int n = rho >> 4, i = rho & 15; return 8 * (i >> 2) + 4 * n + (i & 3); }

struct Unit { int pm, pn; };
struct Gemm { const bf16_t* A; const bf16_t* Bt; int M, N, K; };

struct StaticOrder {
    int nM, nN, nwg, G, c;
    __host__ __device__ void init(int M, int N, int G_, int c_) { nM = M / BM; nN = N / BM; nwg = nM * nN; G = G_; c = c_; }
    __host__ __device__ bool next(int i, Unit& u) const {
        const long L = (long)i * G + c; if (L >= nwg) return false;
        int wgid = (int)L; { const int q = nwg / NXCD, r = nwg % NXCD, xcd = wgid % NXCD, off = wgid / NXCD; wgid = (xcd < r ? xcd * (q + 1) : r * (q + 1) + (xcd - r) * q) + off; }
        const int nig = WGM * nN, gid = wgid / nig, fm = gid * WGM, gsz = (nM - fm) < WGM ? (nM - fm) : WGM;
        u.pm = fm + ((wgid % nig) % gsz); u.pn = (wgid % nig) / gsz; return true;
    }
    __device__ __forceinline__ void a_ready(const Unit&) const {}
    __device__ __forceinline__ void done(const Unit&) const {}
};

__device__ __forceinline__ unsigned cvt_pk_bf16(float lo, float hi) { unsigned r; asm volatile("v_cvt_pk_bf16_f32 %0, %1, %2" : "=v"(r) : "v"(lo), "v"(hi)); return r; }
template <class Epi, class Sched, bool ALIGN_EPI = false, bool SP2 = false>
__device__ __forceinline__ void gemm_phase(PG8_LAS unsigned char* lds, const Gemm g, const Sched& S, const Epi& E) {
    const int tid = tid_opaque(), wid = __builtin_amdgcn_readfirstlane(tid >> 6), lane = tid & 63, wr = wid >> 2, wc = wid & 3, fr = lane & 15, fq = lane >> 4;
    const int K = g.K, nt = K / BK;
    unsigned voffA[2], voffB[2];
#pragma unroll
    for (int i = 0; i < 2; ++i) { int R, C; stage_rc(tid * 16 + i * 8192, R, C); const int Rb = Epi::PERM ? ((R & ~31) + perm32(R & 31)) : R;
        voffA[i] = (unsigned)(R * K + C) * 2u; voffB[i] = (unsigned)(Rb * K + C) * 2u; }
    const size_t kstep = (size_t)(BK * 2);
    const size_t hstep = (size_t)HALF * K * 2;
    const size_t tstep = 2 * hstep;
    const unsigned ldsw = (unsigned)wid * 1024u;
    const int aoff = lds_byte(wr * 64 + fr, fq * 8), boff = lds_byte(wc * 32 + fr, fq * 8);
#define PG8_SA(b, h) (((b) * 2 + (h)) * HTB)
#define PG8_SB(b, h) ((4 + (b) * 2 + (h)) * HTB)
#define PG8_STAGE(bufoff, gbase, voff) do { _Pragma("unroll") for (int _i = 0; _i < 2; ++_i) \
        __builtin_amdgcn_global_load_lds((const unsigned*)((const char*)(gbase) + (voff)[_i]), (PG8_LAS unsigned*)(lds + (bufoff) + ldsw + _i * 8192), 16, 0, 0); } while (0)
#define PG8_LDA(dst, b, h) do { _Pragma("unroll") for (int m = 0; m < 4; ++m) _Pragma("unroll") for (int k = 0; k < 2; ++k) dst[m][k] = *(const PG8_LAS bf16x8*)(lds + PG8_SA(b, h) + aoff + m * 2048 + k * 1024); } while (0)
#define PG8_LDB(dst, b, h) do { _Pragma("unroll") for (int n = 0; n < 2; ++n) _Pragma("unroll") for (int k = 0; k < 2; ++k) dst[n][k] = *(const PG8_LAS bf16x8*)(lds + PG8_SB(b, h) + boff + n * 2048 + k * 1024); } while (0)
#define PG8_MMA(ai, bj, At, Bt) do { __builtin_amdgcn_s_setprio(1); _Pragma("unroll") for (int m = 0; m < 4; ++m) _Pragma("unroll") for (int n = 0; n < 2; ++n) _Pragma("unroll") for (int k = 0; k < 2; ++k) \
        acc[ai][bj][m][n] = __builtin_amdgcn_mfma_f32_16x16x32_bf16(Bt[n][k], At[m][k], acc[ai][bj][m][n], 0, 0, 0); __builtin_amdgcn_s_setprio(0); } while (0)
#define PG8_WAIT_V(n) asm volatile("s_waitcnt vmcnt(" #n ")" ::: "memory")
#define PG8_WAIT_L(n) asm volatile("s_waitcnt lgkmcnt(" #n ")" ::: "memory")
#define PG8_BAR __builtin_amdgcn_s_barrier()
#define PG8_SCHED __builtin_amdgcn_sched_barrier(0)
    Unit cur, nxt; int ui = 0;
    if (!S.next(0, cur)) return;
    f32x4 acc[2][2][4][2];
#pragma unroll
    for (int a = 0; a < 2; ++a)
#pragma unroll
        for (int b = 0; b < 2; ++b)
#pragma unroll
            for (int m = 0; m < 4; ++m)
#pragma unroll
                for (int n = 0; n < 2; ++n) acc[a][b][m][n] = (f32x4){0.f, 0.f, 0.f, 0.f};
    bf16x8 At[4][2], B0[2][2], B1[2][2];
    const char* cA = (const char*)g.A + (size_t)cur.pm * tstep; const char* cB = (const char*)g.Bt + (size_t)cur.pn * tstep;
    S.a_ready(cur);
    if constexpr (SP2) {
        PG8_STAGE(PG8_SB(0, 0), cB, voffB); PG8_STAGE(PG8_SB(0, 1), cB + hstep, voffB); PG8_STAGE(PG8_SA(0, 0), cA, voffA); PG8_STAGE(PG8_SA(0, 1), cA + hstep, voffA);
        if (wr == 1) PG8_BAR;
        PG8_WAIT_V(2); PG8_BAR;
        PG8_STAGE(PG8_SB(1, 0), cB + kstep, voffB); PG8_STAGE(PG8_SA(1, 0), cA + kstep, voffA); PG8_STAGE(PG8_SB(1, 1), cB + hstep + kstep, voffB);
        PG8_WAIT_V(6); PG8_BAR;
    } else {
        PG8_STAGE(PG8_SB(0, 0), cB, voffB); PG8_STAGE(PG8_SA(0, 0), cA, voffA); PG8_STAGE(PG8_SB(0, 1), cB + hstep, voffB); PG8_STAGE(PG8_SA(0, 1), cA + hstep, voffA);
        if (wr == 1) PG8_BAR;
        PG8_WAIT_V(4); PG8_BAR;
        PG8_STAGE(PG8_SB(1, 0), cB + kstep, voffB); PG8_STAGE(PG8_SA(1, 0), cA + kstep, voffA); PG8_STAGE(PG8_SB(1, 1), cB + hstep + kstep, voffB);
        PG8_WAIT_V(6); PG8_BAR;
    }
    for (;;) {
        const bool has_next = S.next(ui + 1, nxt);
        const char* nA = has_next ? (const char*)g.A + (size_t)nxt.pm * tstep : cA; const char* nB = has_next ? (const char*)g.Bt + (size_t)nxt.pn * tstep : cB;
        for (int t = 0; t < nt; t += 2) {
            const bool last = (t == nt - 2);
            const char* a1 = cA + (size_t)(t + 1) * kstep;
            const char* a2 = last ? nA : cA + (size_t)(t + 2) * kstep; const char* b2 = last ? nB : cB + (size_t)(t + 2) * kstep;
            const char* a3 = a2 + kstep; const char* b3 = b2 + kstep;
            if (last && has_next) S.a_ready(nxt);
            if constexpr (SP2) {
            PG8_LDB(B0, 0, 0); PG8_LDB(B1, 0, 1); PG8_SCHED; PG8_LDA(At, 0, 0); PG8_STAGE(PG8_SA(1, 1), a1 + hstep, voffA);
            PG8_WAIT_V(8); PG8_WAIT_L(0); PG8_BAR; PG8_MMA(0, 0, At, B0); PG8_MMA(0, 1, At, B1); PG8_BAR; PG8_SCHED;
            PG8_LDA(At, 0, 1); PG8_STAGE(PG8_SB(0, 0), b2, voffB); PG8_STAGE(PG8_SB(0, 1), b2 + hstep, voffB); PG8_STAGE(PG8_SA(0, 0), a2, voffA);
            PG8_WAIT_V(8); PG8_WAIT_L(0); PG8_BAR; PG8_MMA(1, 0, At, B0); PG8_MMA(1, 1, At, B1); PG8_BAR; PG8_SCHED;
            PG8_LDB(B0, 1, 0); PG8_LDB(B1, 1, 1); PG8_SCHED; PG8_LDA(At, 1, 0); PG8_STAGE(PG8_SA(0, 1), a2 + hstep, voffA);
            PG8_WAIT_V(8); PG8_WAIT_L(0); PG8_BAR; PG8_MMA(0, 0, At, B0); PG8_MMA(0, 1, At, B1); PG8_BAR; PG8_SCHED;
            PG8_LDA(At, 1, 1); PG8_STAGE(PG8_SB(1, 0), b3, voffB); PG8_STAGE(PG8_SB(1, 1), b3 + hstep, voffB); PG8_STAGE(PG8_SA(1, 0), a3, voffA);
            PG8_WAIT_V(8); PG8_WAIT_L(0); PG8_BAR; PG8_MMA(1, 0, At, B0); PG8_MMA(1, 1, At, B1); PG8_BAR; PG8_SCHED;
            } else {
            PG8_LDB(B0, 0, 0); PG8_SCHED; PG8_LDA(At, 0, 0); PG8_STAGE(PG8_SA(1, 1), a1 + hstep, voffA);
            PG8_WAIT_L(8); PG8_BAR; PG8_WAIT_L(0); PG8_MMA(0, 0, At, B0); PG8_BAR; PG8_SCHED;
            PG8_LDB(B1, 0, 1); PG8_STAGE(PG8_SB(0, 0), b2, voffB);
            PG8_BAR; PG8_WAIT_L(0); PG8_MMA(0, 1, At, B1); PG8_BAR;
            PG8_LDA(At, 0, 1); PG8_STAGE(PG8_SA(0, 0), a2, voffA);
            PG8_BAR; PG8_WAIT_L(0); PG8_MMA(1, 0, At, B0); PG8_BAR; PG8_SCHED;
            PG8_STAGE(PG8_SB(0, 1), b2 + hstep, voffB);
            PG8_WAIT_V(6); PG8_BAR; PG8_MMA(1, 1, At, B1); PG8_BAR;
            PG8_LDB(B0, 1, 0); PG8_SCHED; PG8_LDA(At, 1, 0); PG8_STAGE(PG8_SA(0, 1), a2 + hstep, voffA);
            PG8_WAIT_L(8); PG8_BAR; PG8_WAIT_L(0); PG8_MMA(0, 0, At, B0); PG8_BAR; PG8_SCHED;
            PG8_LDB(B1, 1, 1); PG8_STAGE(PG8_SB(1, 0), b3, voffB);
            PG8_BAR; PG8_WAIT_L(0); PG8_MMA(0, 1, At, B1); PG8_BAR;
            PG8_LDA(At, 1, 1); PG8_STAGE(PG8_SA(1, 0), a3, voffA);
            PG8_BAR; PG8_WAIT_L(0); PG8_MMA(1, 0, At, B0); PG8_BAR; PG8_SCHED;
            PG8_STAGE(PG8_SB(1, 1), b3 + hstep, voffB);
            PG8_WAIT_V(6); PG8_BAR; PG8_MMA(1, 1, At, B1); PG8_BAR;
            }
        }
        if constexpr (ALIGN_EPI) { if (wr == 0) PG8_BAR; }
        if constexpr (!Epi::AFTER_DRAIN) { E(acc, cur, wr, wc, fr, fq); S.done(cur); }
        if (!has_next) break;
#pragma unroll
        for (int a = 0; a < 2; ++a)
#pragma unroll
            for (int b = 0; b < 2; ++b)
#pragma unroll
                for (int m = 0; m < 4; ++m)
#pragma unroll
                    for (int n = 0; n < 2; ++n) acc[a][b][m][n] = (f32x4){0.f, 0.f, 0.f, 0.f};
        cur = nxt; cA = nA; cB = nB; ++ui;
        if constexpr (ALIGN_EPI) { if (wr == 1) PG8_BAR; }
    }
    PG8_WAIT_V(0);
    if constexpr (!ALIGN_EPI) { if (wr == 0) PG8_BAR; }
    PG8_BAR;
    if constexpr (Epi::AFTER_DRAIN) { E.fused(acc, cur, wr, wc, fr, fq, lds, wid, lane); S.done(cur); }
#undef PG8_SA
#undef PG8_SB
#undef PG8_STAGE
#undef PG8_LDA
#undef PG8_LDB
#undef PG8_MMA
#undef PG8_WAIT_V
#undef PG8_WAIT_L
#undef PG8_BAR
#undef PG8_SCHED
}
}
typedef unsigned short bf16_t;
typedef short bf16x8 __attribute__((ext_vector_type(8)));
typedef short s16x4 __attribute__((ext_vector_type(4)));
typedef float f32x4 __attribute__((ext_vector_type(4)));
typedef float f32x16 __attribute__((ext_vector_type(16)));
typedef unsigned u32x4 __attribute__((ext_vector_type(4)));
typedef unsigned u32x2 __attribute__((ext_vector_type(2)));
#define LAS __attribute__((address_space(3)))

constexpr int T = 16384, SEQ = 8192, DM = 1024, DFF = 2816, NFF = 5632, CIN_SRC = 5504, NWIN = 5632, NLORA = 2560, KLORA = 384;
constexpr int NPH = 15, DEPTH = 4;
constexpr float LOG2E = 1.4426950408889634f;
constexpr size_t MiB = 1u << 20;
constexpr size_t WS_CTL = 0;
constexpr size_t WS_WA = 1 * MiB;
constexpr size_t WS_WB = 13 * MiB;
constexpr size_t WS_WL = 438 * MiB;
constexpr size_t WS_WR = 440 * MiB;
constexpr size_t WS_WO = 444 * MiB;
constexpr size_t WS_XN = 22 * MiB;
constexpr size_t WS_ACT = 54 * MiB;
constexpr size_t WS_H = WS_ACT;
constexpr size_t WS_PR = WS_ACT;
constexpr size_t WS_WF = WS_ACT, WS_WBK = WS_ACT + 32 * MiB, WS_AO = WS_ACT;
constexpr size_t WS_QKV = WS_ACT + 64 * MiB;
constexpr size_t WS_G = WS_ACT + 112 * MiB;
constexpr size_t WS_R = WS_ACT + 176 * MiB, WS_K = WS_R + 16 * MiB, WS_V = WS_R + 32 * MiB, WS_KK = WS_R + 48 * MiB;
constexpr size_t WS_AF = WS_ACT + 240 * MiB, WS_AB = WS_AF + 16 * MiB;
constexpr size_t WS_GATE = WS_ACT + 272 * MiB;
constexpr size_t WS_YF = WS_ACT + 320 * MiB, WS_YB = WS_YF + 16 * MiB;
constexpr size_t WS_LIN = WS_YF;
constexpr size_t WS_O0 = WS_ACT + 352 * MiB, WS_O1 = WS_O0 + 16 * MiB;
constexpr size_t WS_PT = WS_XN;
constexpr size_t WS_LC = WS_ACT + 288 * MiB;
constexpr size_t WS_END = 447 * MiB;
static_assert(WS_ACT + 384 * MiB == WS_WL, "mixer weights sit right after the activation map");
constexpr int LDS_BYTES = 131072 + 1024;

static_assert(WS_WBK == WS_WF + 32 * MiB && WS_AB == WS_AF + 16 * MiB && WS_GATE == WS_AF + 32 * MiB, "contiguous outputs");
struct Params { const float* in[26]; float* out; unsigned char* ws; int ph_lo, ph_hi; };

__device__ __forceinline__ float bf2f(unsigned short u) { return __uint_as_float(((unsigned)u) << 16); }
__device__ __forceinline__ float bflo(unsigned w) { return __uint_as_float(w << 16); }
__device__ __forceinline__ float bfhi(unsigned w) { return __uint_as_float(w & 0xffff0000u); }
typedef float f32x2n __attribute__((ext_vector_type(2)));
typedef __bf16 bf16x2n __attribute__((ext_vector_type(2)));
__device__ __forceinline__ unsigned pk2(float lo, float hi) { f32x2n v = {lo, hi}; return __builtin_bit_cast(unsigned, __builtin_convertvector(v, bf16x2n)); }
__device__ __forceinline__ unsigned short f2bf(float f) { return (unsigned short)(pk2(f, 0.f) & 0xffffu); }
__device__ __forceinline__ float sigm(float x) { return 1.0f / (1.0f + __expf(-x)); }
__device__ __forceinline__ void unpack8(u32x4 w, float* f) { f[0] = bflo(w.x); f[1] = bfhi(w.x); f[2] = bflo(w.y); f[3] = bfhi(w.y); f[4] = bflo(w.z); f[5] = bfhi(w.z); f[6] = bflo(w.w); f[7] = bfhi(w.w); }
__device__ __forceinline__ u32x4 pack8(const float* f) { u32x4 w; w.x = pk2(f[0], f[1]); w.y = pk2(f[2], f[3]); w.z = pk2(f[4], f[5]); w.w = pk2(f[6], f[7]); return w; }
__device__ __forceinline__ float wave_sum(float v) { v += __shfl_xor(v, 32); v += __shfl_xor(v, 16); v += __shfl_xor(v, 8); v += __shfl_xor(v, 4); v += __shfl_xor(v, 2); v += __shfl_xor(v, 1); return v; }

struct EpiSwiGLU {
    static constexpr bool PERM = true, AFTER_DRAIN = false;
    bf16_t* H;
    __device__ __forceinline__ void operator()(const f32x4 (&acc)[2][2][4][2], const pg8::Unit& u, int wr, int wc, int fr, int fq) const {
        const int row0 = u.pm * 256 + wr * 64 + fr, col0 = u.pn * 128 + wc * 32 + 8 * fq;
#pragma unroll
        for (int ai = 0; ai < 2; ++ai)
#pragma unroll
            for (int m = 0; m < 4; ++m) {
                float o[8];
#pragma unroll
                for (int n = 0; n < 2; ++n)
#pragma unroll
                    for (int j = 0; j < 4; ++j) { const float g = acc[ai][0][m][n][j], up = acc[ai][1][m][n][j]; o[4 * n + j] = g * up * __builtin_amdgcn_rcpf(1.0f + __builtin_amdgcn_exp2f(-g * LOG2E)); }
                *(u32x4*)(H + (size_t)(row0 + ai * 128 + m * 16) * DFF + col0) = pack8(o);
            }
    }
};
struct EpiResid {
    static constexpr bool PERM = false, AFTER_DRAIN = false;
    const float* base; float* out; float scale;
    __device__ __forceinline__ void operator()(const f32x4 (&acc)[2][2][4][2], const pg8::Unit& u, int wr, int wc, int fr, int fq) const {
        const int col0 = u.pn * 256 + wc * 32 + 4 * fq;
#pragma unroll
        for (int ai = 0; ai < 2; ++ai)
#pragma unroll
            for (int m = 0; m < 4; ++m) {
                const size_t off = (size_t)(u.pm * 256 + ai * 128 + wr * 64 + m * 16 + fr) * DM + col0;
#pragma unroll
                for (int bj = 0; bj < 2; ++bj)
#pragma unroll
                    for (int n = 0; n < 2; ++n) { const f32x4 b = *(const f32x4*)(base + off + bj * 128 + n * 16); *(f32x4*)(out + off + bj * 128 + n * 16) = b + acc[ai][bj][m][n] * scale; }
            }
    }
};
struct EpiWin {
    static constexpr bool PERM = true, AFTER_DRAIN = false;
    bf16_t *PR, *QKV, *G;
    __device__ __forceinline__ void operator()(const f32x4 (&acc)[2][2][4][2], const pg8::Unit& u, int wr, int wc, int fr, int fq) const {
        const int row0 = u.pm * 256 + wr * 64 + fr; const int lc0 = wc * 32 + 8 * fq;
        bf16_t* base; int ld, colt; bool sg = false;
        if (u.pn < 8) { base = PR; ld = 2048; colt = u.pn * 256; } else if (u.pn < 14) { base = QKV; ld = 1536; colt = (u.pn - 8) * 256; } else { base = G; ld = 2048; colt = (u.pn - 14) * 256; sg = true; }
#pragma unroll
        for (int ai = 0; ai < 2; ++ai)
#pragma unroll
            for (int m = 0; m < 4; ++m) {
                bf16_t* rowp = base + (size_t)(row0 + ai * 128 + m * 16) * ld + colt + lc0;
#pragma unroll
                for (int bj = 0; bj < 2; ++bj) { float o[8];
#pragma unroll
                    for (int n = 0; n < 2; ++n)
#pragma unroll
                        for (int j = 0; j < 4; ++j) { float v = acc[ai][bj][m][n][j]; if (sg) v = __builtin_amdgcn_rcpf(1.0f + __builtin_amdgcn_exp2f(-v * LOG2E)); o[4 * n + j] = v; }
                    *(u32x4*)(rowp + bj * 128) = pack8(o); }
            }
    }
};
struct EpiDecay {
    static constexpr bool PERM = true, AFTER_DRAIN = false;
    const float* w0; float *Wf, *Wb;
    __device__ __forceinline__ void operator()(const f32x4 (&acc)[2][2][4][2], const pg8::Unit& u, int wr, int wc, int fr, int fq) const {
        const int row0 = u.pm * 256 + wr * 64 + fr; const int g = u.pn >> 1; const int cb = (u.pn & 1) * 256 + wc * 32 + 8 * fq;
        float* Wd = Wf + (size_t)g * (32 * MiB / 4);
#pragma unroll
        for (int bj = 0; bj < 2; ++bj) {
            const int c = cb + bj * 128;
            const f32x4 z0 = *(const f32x4*)(w0 + g * 512 + c), z1 = *(const f32x4*)(w0 + g * 512 + c + 4);
#pragma unroll
            for (int ai = 0; ai < 2; ++ai)
#pragma unroll
                for (int m = 0; m < 4; ++m) { const size_t off = (size_t)(row0 + ai * 128 + m * 16) * 512 + c; f32x4 o0, o1;
#pragma unroll
                    for (int j = 0; j < 4; ++j) {
                        const float s0 = __builtin_amdgcn_rcpf(1.0f + __builtin_amdgcn_exp2f(-LOG2E * (z0[j] + acc[ai][bj][m][0][j])));
                        const float s1 = __builtin_amdgcn_rcpf(1.0f + __builtin_amdgcn_exp2f(-LOG2E * (z1[j] + acc[ai][bj][m][1][j])));
                        o0[j] = -0.6065306597126334f * s0; o1[j] = -0.6065306597126334f * s1; }
                    *(f32x4*)(Wd + off) = o0; *(f32x4*)(Wd + off + 4) = o1; }
        }
    }
};
struct EpiIclr {
    static constexpr bool PERM = true, AFTER_DRAIN = false;
    const float* a0; bf16_t *Af, *Ab, *GATE;
    __device__ __forceinline__ void operator()(const f32x4 (&acc)[2][2][4][2], const pg8::Unit& u, int wr, int wc, int fr, int fq) const {
        const int row0 = u.pm * 256 + wr * 64 + fr; const int kind = u.pn >> 1; const int cb = (u.pn & 1) * 256 + wc * 32 + 8 * fq;
        bf16_t* Bd = Af + (size_t)kind * (16 * MiB / 2); const bool sg = kind < 2;
#pragma unroll
        for (int bj = 0; bj < 2; ++bj) {
            const int c = cb + bj * 128;
            f32x4 z0 = (f32x4){0.f, 0.f, 0.f, 0.f}, z1 = z0;
            if (sg) { z0 = *(const f32x4*)(a0 + kind * 512 + c); z1 = *(const f32x4*)(a0 + kind * 512 + c + 4); }
#pragma unroll
            for (int ai = 0; ai < 2; ++ai)
#pragma unroll
                for (int m = 0; m < 4; ++m) { const size_t off = (size_t)(row0 + ai * 128 + m * 16) * 512 + c; float o[8];
#pragma unroll
                    for (int j = 0; j < 4; ++j) { o[j] = z0[j] + acc[ai][bj][m][0][j]; o[4 + j] = z1[j] + acc[ai][bj][m][1][j]; }
                    if (sg) {
#pragma unroll
                        for (int j = 0; j < 8; ++j) o[j] = __builtin_amdgcn_rcpf(1.0f + __builtin_amdgcn_exp2f(-LOG2E * o[j]));
                    }
                    *(u32x4*)(Bd + off) = pack8(o); }
        }
    }
};
struct EpiBranch {
    static constexpr bool PERM = true, AFTER_DRAIN = false;
    const bf16_t* G; bf16_t* MG;
    __device__ __forceinline__ void operator()(const f32x4 (&acc)[2][2][4][2], const pg8::Unit& u, int wr, int wc, int fr, int fq) const {
        const int row0 = u.pm * 256 + wr * 64 + fr, c = u.pn * 128 + wc * 32 + 8 * fq;
#pragma unroll
        for (int ai = 0; ai < 2; ++ai)
#pragma unroll
            for (int m = 0; m < 4; ++m) { const size_t r = (size_t)(row0 + ai * 128 + m * 16);
                float g0[8], g1[8], o[8]; unpack8(*(const u32x4*)(G + r * 2048 + c), g0); unpack8(*(const u32x4*)(G + r * 2048 + 1024 + c), g1);
#pragma unroll
                for (int n = 0; n < 2; ++n)
#pragma unroll
                    for (int j = 0; j < 4; ++j) o[4 * n + j] = g0[4 * n + j] * acc[ai][0][m][n][j] + g1[4 * n + j] * acc[ai][1][m][n][j];
                *(u32x4*)(MG + r * 1024 + c) = pack8(o); asm volatile("" ::: "memory"); }
    }
};
__device__ __forceinline__ void cvt_tile(unsigned char* lds, const float* src, int ld, int n_begin, int K, bf16_t* dst, int Kd, int koff, int mode, int roff, int t, int tid) {
    const int ntk = Kd / 64; unsigned short* tile = (unsigned short*)lds;
    const int tn = t / ntk, tk = t - tn * ntk; const int n0 = tn * 64, k0 = tk * 64;
    const bool valid = (src != nullptr) && (k0 >= koff) && (k0 < koff + K);
    __syncthreads();
    if (valid) {
#pragma unroll
        for (int it = 0; it < 2; ++it) { const int idx = tid + 512 * it, kr = idx >> 4, nc4 = idx & 15;
            const f32x4 v = *(const f32x4*)(src + (size_t)(k0 - koff + kr) * ld + n_begin + n0 + 4 * nc4);
#pragma unroll
            for (int j = 0; j < 4; ++j) tile[(4 * nc4 + j) * 66 + kr] = f2bf(v[j]); }
    }
    __syncthreads();
    { const int n = tid >> 3, kc = (tid & 7) * 8; u32x4 w = (u32x4){0u, 0u, 0u, 0u};
      if (valid) { const unsigned* tp = (const unsigned*)(tile + n * 66 + kc); w.x = tp[0]; w.y = tp[1]; w.z = tp[2]; w.w = tp[3]; }
      const int nl = n0 + n; const int drow = (mode == 0) ? (nl + roff) : (256 * (nl >> 7) + (nl & 127) + roff);
      *(u32x4*)(dst + (size_t)drow * Kd + k0 + kc) = w; }
}
__device__ __forceinline__ void cvt_job(unsigned char* lds, const float* src, int ld, int n_begin, int n_count, int K, bf16_t* dst, int Kd, int koff, int mode, int roff, int& cum) {
    const int tid = tid_opaque(), G = gridDim.x; const int bid = bid_opaque();
    const int ntiles = (n_count / 64) * (Kd / 64);
    const int start = (int)(((unsigned)bid + (unsigned)G - (unsigned)(cum % G)) % (unsigned)G);
    for (int t = start; t < ntiles; t += G) cvt_tile(lds, src, ld, n_begin, K, dst, Kd, koff, mode, roff, t, tid);
    cum += ntiles;
}
constexpr int CVT_FFN_TILES = 3 * 704;
__device__ __forceinline__ void cvt_ffn_tile(unsigned char* lds, unsigned char* ws, const float* w_in, const float* w_out, int gt, int tid) {
    bf16_t* WA = (bf16_t*)(ws + WS_WA); bf16_t* WB = (bf16_t*)(ws + WS_WB);
    if (gt < 704) cvt_tile(lds, w_in, NFF, 0, DM, WA, DM, 0, 1, 0, gt, tid);
    else if (gt < 1408) cvt_tile(lds, w_in, NFF, DFF, DM, WA, DM, 0, 1, 128, gt - 704, tid);
    else cvt_tile(lds, w_out, DM, 0, DFF, WB, DFF, 0, 0, 0, gt - 1408, tid);
}
__device__ void cvt_ffn(unsigned char* lds, unsigned char* ws, const float* w_in, const float* w_out) {
    int cum = 0; bf16_t* WA = (bf16_t*)(ws + WS_WA); bf16_t* WB = (bf16_t*)(ws + WS_WB);
    cvt_job(lds, w_in, NFF, 0, DFF, DM, WA, DM, 0, 1, 0, cum);
    cvt_job(lds, w_in, NFF, DFF, DFF, DM, WA, DM, 0, 1, 128, cum);
    cvt_job(lds, w_out, DM, 0, DM, DFF, WB, DFF, 0, 0, 0, cum);
}
__device__ void cvt_mixer(unsigned char* lds, unsigned char* ws, const float* w_in, const float* dw2, const float* ia2, const float* gg2, const float* wbr, const float* wout) {
    int cum = 0; bf16_t* WA = (bf16_t*)(ws + WS_WA); bf16_t* WL = (bf16_t*)(ws + WS_WL); bf16_t* WR = (bf16_t*)(ws + WS_WR); bf16_t* WO = (bf16_t*)(ws + WS_WO);
    cvt_job(lds, w_in, CIN_SRC, 0, 1920, DM, WA, DM, 0, 0, 0, cum);
    cvt_job(lds, nullptr, 0, 0, 128, 0, WA, DM, 0, 0, 1920, cum);
    cvt_job(lds, w_in, CIN_SRC, 1920, 3584, DM, WA, DM, 0, 0, 2048, cum);
    cvt_job(lds, dw2, 512, 0, 512, 64, WL, KLORA, 0, 0, 0, cum);
    cvt_job(lds, dw2 + 64 * 512, 512, 0, 512, 64, WL, KLORA, 64, 0, 512, cum);
    cvt_job(lds, ia2, 512, 0, 512, 64, WL, KLORA, 128, 0, 1024, cum);
    cvt_job(lds, ia2 + 64 * 512, 512, 0, 512, 64, WL, KLORA, 192, 0, 1536, cum);
    cvt_job(lds, gg2, 512, 0, 512, 128, WL, KLORA, 256, 0, 2048, cum);
    cvt_job(lds, wbr, DM, 0, DM, 512, WR, DM, 0, 1, 0, cum);
    cvt_job(lds, wbr + 512 * DM, DM, 0, DM, 512, WR, DM, 512, 1, 128, cum);
    cvt_job(lds, wout, DM, 0, DM, DM, WO, DM, 0, 0, 0, cum);
}
__device__ void norm_rows(const float* x, const float* g, bf16_t* xn) {
    const int tid_ = tid_opaque(); const int lane = tid_ & 63, gw = bid_opaque() * 8 + (tid_ >> 6), nw = gridDim.x * 8;
    f32x4 gv[4];
#pragma unroll
    for (int i = 0; i < 4; ++i) gv[i] = *(const f32x4*)(g + 4 * lane + 256 * i);
#pragma unroll 2
    for (int row = gw; row < T; row += nw) {
        const float* xr = x + (size_t)row * DM; f32x4 v[4]; float ss = 0.f;
#pragma unroll
        for (int i = 0; i < 4; ++i) { v[i] = *(const f32x4*)(xr + 4 * lane + 256 * i); ss += v[i][0] * v[i][0] + v[i][1] * v[i][1] + v[i][2] * v[i][2] + v[i][3] * v[i][3]; }
        ss = wave_sum(ss); const float rs = rsqrtf(ss * (1.0f / 1024.0f) + 1e-6f);
#pragma unroll
        for (int i = 0; i < 4; ++i) { u32x2 w; w.x = pk2(v[i][0] * rs * gv[i][0], v[i][1] * rs * gv[i][1]); w.y = pk2(v[i][2] * rs * gv[i][2], v[i][3] * rs * gv[i][3]);
            *(u32x2*)(xn + (size_t)row * DM + 4 * lane + 256 * i) = w; }
    }
}
__device__ void prep_phase(const Params& P, int l) {
    unsigned char* ws = P.ws;
    const bf16_t* PR = (const bf16_t*)(ws + WS_PR); bf16_t* QKV = (bf16_t*)(ws + WS_QKV);
    bf16_t* R = (bf16_t*)(ws + WS_R); bf16_t* Kb = (bf16_t*)(ws + WS_K); bf16_t* V = (bf16_t*)(ws + WS_V); bf16_t* KK = (bf16_t*)(ws + WS_KK); bf16_t* LIN = (bf16_t*)(ws + WS_LIN);
    const float* mu = P.in[6] + l * 1920; const float* k_k = P.in[12] + l * 512; const float* qg = P.in[17] + l * 64; const float* kg = P.in[18] + l * 64;
    const int tid_ = tid_opaque(); const int lane = tid_ & 63, gw = bid_opaque() * 8 + (tid_ >> 6), nw = gridDim.x * 8;
    f32x4 muA[4], muB[4];
#pragma unroll
    for (int i = 0; i < 4; ++i) { const int ch = lane + 64 * i; const int c0 = ch < 240 ? 8 * ch : 0; muA[i] = *(const f32x4*)(mu + c0); muB[i] = *(const f32x4*)(mu + c0 + 4); }
    const f32x4 kkA = *(const f32x4*)(k_k + 8 * lane), kkB = *(const f32x4*)(k_k + 8 * lane + 4);
    const f32x4 g0 = *(const f32x4*)(qg + ((8 * lane) & 63)), g1 = *(const f32x4*)(qg + ((8 * lane) & 63) + 4), h0 = *(const f32x4*)(kg + ((8 * lane) & 63)), h1 = *(const f32x4*)(kg + ((8 * lane) & 63) + 4);
    const int tpw = (T + nw - 1) / nw; const int tbeg = gw * tpw, tend = (tbeg + tpw < T) ? tbeg + tpw : T;
    int coff[4];
#pragma unroll
    for (int i = 0; i < 4; ++i) { const int ch = lane + 64 * i; coff[i] = ch < 240 ? 8 * ch : 0; }
    const u32x4 zero4 = (u32x4){0u, 0u, 0u, 0u};
    u32x4 rp[4], rc[4], rn[4], rnn[4];
#pragma unroll
    for (int i = 0; i < 4; ++i) { rp[i] = zero4; rc[i] = zero4; rn[i] = zero4; rnn[i] = zero4; }
    if (tbeg < tend) {
#pragma unroll
        for (int i = 0; i < 4; ++i) { const bf16_t* pr0 = PR + (size_t)tbeg * 2048 + coff[i]; rc[i] = *(const u32x4*)pr0;
            if (tbeg > 0) rp[i] = *(const u32x4*)(pr0 - 2048);
            if (tbeg + 1 < T) rn[i] = *(const u32x4*)(pr0 + 2048); }
    }
    for (int tok = tbeg; tok < tend; ++tok) {
        const int s = tok & (SEQ - 1);
        const bool has_nn = tok + 2 < T;
#pragma unroll
        for (int i = 0; i < 4; ++i) rnn[i] = has_nn ? *(const u32x4*)(PR + (size_t)(tok + 2) * 2048 + coff[i]) : zero4;
#pragma unroll
        for (int i = 0; i < 4; ++i) {
            const int ch = lane + 64 * i; const bool ok = ch < 240; const int c0 = ok ? 8 * ch : 0;
            float cur[8], prv[8], nxt[8], p[8];
            unpack8(rc[i], cur); unpack8(s > 0 ? rp[i] : zero4, prv); unpack8(s < SEQ - 1 ? rn[i] : zero4, nxt);
            const f32x4 m0 = muA[i], m1 = muB[i];
#pragma unroll
            for (int j = 0; j < 8; ++j) { const float m = j < 4 ? m0[j] : m1[j - 4]; p[j] = cur[j] + m * (0.5f * (prv[j] + nxt[j]) - cur[j]); }
            const bool isk = ok && c0 >= 512 && c0 < 1024; const int ck = isk ? c0 - 512 : 0;
            const f32x4 kk0 = kkA, kk1 = kkB;
            float kkv[8]; float ss = 0.f;
#pragma unroll
            for (int j = 0; j < 8; ++j) { kkv[j] = p[j] * (j < 4 ? kk0[j] : kk1[j - 4]); ss += kkv[j] * kkv[j]; }
            ss += __shfl_xor(ss, 1); ss += __shfl_xor(ss, 2); ss += __shfl_xor(ss, 4);
            const float inv = 1.0f / fmaxf(sqrtf(ss), 1e-12f);
            if (ok) {
                if (c0 < 512) *(u32x4*)(R + (size_t)tok * 512 + c0) = pack8(p);
                else if (c0 < 1024) { *(u32x4*)(Kb + (size_t)tok * 512 + ck) = pack8(p);
#pragma unroll
                    for (int j = 0; j < 8; ++j) kkv[j] *= inv;
                    *(u32x4*)(KK + (size_t)tok * 512 + ck) = pack8(kkv); }
                else if (c0 < 1536) *(u32x4*)(V + (size_t)tok * 512 + (c0 - 1024)) = pack8(p);
                else { float o[8];
                    if (c0 < 1664) { for (int j = 0; j < 8; ++j) o[j] = tanhf(p[j]); }
                    else if (c0 < 1792) { for (int j = 0; j < 8; ++j) o[j] = p[j]; }
                    else { for (int j = 0; j < 8; ++j) o[j] = sigm(p[j]); }
                    *(u32x4*)(LIN + (size_t)tok * KLORA + (c0 - 1536)) = pack8(o); }
            }
        }
        { const int c0 = 8 * lane; bf16_t* qp = QKV + (size_t)tok * 1536 + c0;
          float q[8], k[8]; unpack8(*(const u32x4*)qp, q); unpack8(*(const u32x4*)(qp + 512), k);
          float sq = 0.f, sk = 0.f;
#pragma unroll
          for (int j = 0; j < 8; ++j) { sq += q[j] * q[j]; sk += k[j] * k[j]; }
          sq += __shfl_xor(sq, 1); sq += __shfl_xor(sq, 2); sq += __shfl_xor(sq, 4); sk += __shfl_xor(sk, 1); sk += __shfl_xor(sk, 2); sk += __shfl_xor(sk, 4);
          const float rq = rsqrtf(sq * (1.0f / 64.0f) + 1e-6f) * (0.125f * LOG2E), rk = rsqrtf(sk * (1.0f / 64.0f) + 1e-6f);
#pragma unroll
          for (int j = 0; j < 8; ++j) { q[j] *= rq * (j < 4 ? g0[j] : g1[j - 4]); k[j] *= rk * (j < 4 ? h0[j] : h1[j - 4]); }
          *(u32x4*)qp = pack8(q); *(u32x4*)(qp + 512) = pack8(k); }
#pragma unroll
        for (int i = 0; i < 4; ++i) { rp[i] = rc[i]; rc[i] = rn[i]; rn[i] = rnn[i]; }
    }
}
namespace ck {
constexpr int LDP = 72, SLOT = 64 * LDP * 2;
__device__ __forceinline__ int crow(int r, int hi) { return (r & 3) + 8 * (r >> 2) + 4 * hi; }
__device__ __forceinline__ void ldf(const unsigned char* buf, int row0, int lane, bf16x8 (&f)[4]) {
    const unsigned char* p = buf + ((row0 + (lane & 31)) * LDP + 8 * (lane >> 5)) * 2;
#pragma unroll
    for (int s = 0; s < 4; ++s) f[s] = *(const bf16x8*)(p + 32 * s);
}
__device__ __forceinline__ void ldf_g(const bf16_t* g, int row0, int lane, bf16x8 (&f)[4]) {
    const bf16_t* p = g + (row0 + (lane & 31)) * 64 + 8 * (lane >> 5);
#pragma unroll
    for (int s = 0; s < 4; ++s) f[s] = *(const bf16x8*)(p + 16 * s);
}
__device__ __forceinline__ void mma4(f32x16& acc, const bf16x8 (&a)[4], const bf16x8 (&b)[4]) {
#pragma unroll
    for (int s = 0; s < 4; ++s) acc = __builtin_amdgcn_mfma_f32_32x32x16_bf16(a[s], b[s], acc, 0, 0, 0);
}
template <int MASK> __device__ __forceinline__ float mval(float v, int row, int col) { if (MASK == 1) return col < row ? v : 0.f; if (MASK == 2) return col <= row ? v : 0.f; return v; }
template <int MASK> __device__ __forceinline__ void st_n(unsigned char* buf, int m0, int n0, int lane, const f32x16& acc) {
    const int hi = lane >> 5, col = n0 + (lane & 31);
#pragma unroll
    for (int r = 0; r < 16; ++r) { const int row = m0 + crow(r, hi); *(unsigned short*)(buf + (row * LDP + col) * 2) = f2bf(mval<MASK>(acc[r], row, col)); }
}
template <int MASK> __device__ __forceinline__ void st_t(unsigned char* buf, int m0, int n0, int lane, const f32x16& acc) {
    const int hi = lane >> 5, col = n0 + (lane & 31);
#pragma unroll
    for (int g = 0; g < 4; ++g) { const int row = m0 + 8 * g + 4 * hi; u32x2 w;
        w.x = pk2(mval<MASK>(acc[4 * g + 0], row + 0, col), mval<MASK>(acc[4 * g + 1], row + 1, col)); w.y = pk2(mval<MASK>(acc[4 * g + 2], row + 2, col), mval<MASK>(acc[4 * g + 3], row + 3, col));
        *(u32x2*)(buf + (col * LDP + row) * 2) = w; }
}
__device__ __forceinline__ f32x16 zero16() { return f32x16{0.f, 0.f, 0.f, 0.f, 0.f, 0.f, 0.f, 0.f, 0.f, 0.f, 0.f, 0.f, 0.f, 0.f, 0.f, 0.f}; }

template <int MODE> __device__ void chunk_pass(unsigned char* lds, unsigned char* ws, const float* k_a) {
    const int tid = tid_opaque(), w = __builtin_amdgcn_readfirstlane(tid >> 6), lane0 = tid & 63;
    const int q = w & 3, m0 = (q >> 1) * 32, n0 = (q & 1) * 32;
    const int bid = bid_opaque();
#define SL(i) (lds + (i) * SLOT)
    float* segsum = (float*)(lds + 11 * SLOT); float* gC = segsum + 512; float* Lf = gC + 64; unsigned char* SC = (unsigned char*)(Lf + 4096);
    const bf16_t* R = (const bf16_t*)(ws + WS_R); const bf16_t* V = (const bf16_t*)(ws + WS_V); const bf16_t* KK = (const bf16_t*)(ws + WS_KK); const bf16_t* Kb = (const bf16_t*)(ws + WS_K);
    for (int it = 0; ; ++it) {
        const int pidx = bid + (int)gridDim.x * (it >> 1); if (pidx >= 2048) break;
        const int dir = it & 1, bh = pidx >> 7, cc = pidx & 127, b = bh >> 3, h = bh & 7, c = dir ? 127 - cc : cc;
        const int inst = (b << 4) | (h << 1) | dir; const int ci = (inst << 7) + c;
        int lane = lane0; asm volatile("" : "+v"(lane)); const int hi = lane >> 5, l32 = lane & 31;
        const float* LW = (const float*)(ws + (dir ? WS_WBK : WS_WF)); const bf16_t* Ag = (const bf16_t*)(ws + (dir ? WS_AB : WS_AF));
        const int colbase = h * 64; const size_t tb = (size_t)b * SEQ;
        const float kav = k_a[colbase + lane];
        float kk[8], lw[8], a[8], kx[8], rr[8], vv[8];
#pragma unroll
        for (int i = 0; i < 8; ++i) { const int step = 64 * c + 8 * w + i; const size_t off = (tb + (size_t)(dir ? (SEQ - 1 - step) : step)) * 512 + colbase + lane;
            kk[i] = bf2f(KK[off]); lw[i] = LW[off]; a[i] = bf2f(Ag[off]); kx[i] = bf2f(Kb[off]); rr[i] = bf2f(R[off]); vv[i] = bf2f(V[off]); }
        float pf[8]; pf[0] = lw[0];
#pragma unroll
        for (int i = 1; i < 8; ++i) pf[i] = pf[i - 1] + lw[i];
        segsum[w * 64 + lane] = pf[7];
        __syncthreads();
        float offs = 0.f, tot = 0.f;
#pragma unroll
        for (int jj = 0; jj < 8; ++jj) { const float sv = segsum[jj * 64 + lane]; if (jj < w) offs += sv; tot += sv; }
        { float aT[8], b2T[8], k2T[8];
#pragma unroll
          for (int i = 0; i < 8; ++i) { const int t = 8 * w + i; const float Lt = offs + pf[i], Lp = Lt - lw[i];
              const float ea = __expf(Lp), eb = __expf(-Lt), ec = __expf(tot - Lt);
              const float bv = kk[i] * a[i], kd = kx[i] * (1.0f + (a[i] - 1.0f) * kav);
              const float alpha = -kk[i] * ea;
              *(unsigned short*)(SL(0) + (t * LDP + lane) * 2) = f2bf(alpha);
              *(unsigned short*)(SL(2) + (t * LDP + lane) * 2) = f2bf(bv * eb);
              *(unsigned short*)(SL(3) + (t * LDP + lane) * 2) = f2bf(kd * eb);
              if (MODE >= 1) *(unsigned short*)(SL(1) + (t * LDP + lane) * 2) = f2bf(rr[i] * __expf(Lt));
              aT[i] = alpha; b2T[i] = bv * ec; k2T[i] = kd * ec; }
          *(u32x4*)(SL(4) + (lane * LDP + 8 * w) * 2) = pack8(aT);
          *(u32x4*)(SL(5) + (lane * LDP + 8 * w) * 2) = pack8(vv);
          if (MODE != 1) { *(u32x4*)(SL(6) + (lane * LDP + 8 * w) * 2) = pack8(b2T); *(u32x4*)(SL(7) + (lane * LDP + 8 * w) * 2) = pack8(k2T); if (w == 0) gC[lane] = __expf(tot); } }
        __syncthreads();
        { bf16x8 fa[4], fb[4], fr[4];
          ldf(SL(0), m0, lane, fa); ldf(w < 4 ? SL(3) : SL(2), n0, lane, fb); if (MODE >= 1) ldf(SL(1), m0, lane, fr);
          f32x16 acc1 = zero16(), acc2 = zero16(); mma4(acc1, fa, fb); if (MODE >= 1) mma4(acc2, fr, fb);
          __syncthreads();
          if (w < 4) { st_n<1>(SL(8), m0, n0, lane, acc1); if (MODE >= 1) st_n<2>(SL(10), m0, n0, lane, acc2);
              for (int z = tid; z < 2 * (SLOT / 16); z += 256) *(u32x4*)(SL(2) + z * 16) = (u32x4){0u, 0u, 0u, 0u};
          } else {
#pragma unroll
              for (int r = 0; r < 16; ++r) { const int row = m0 + crow(r, hi), col = n0 + l32; acc1[r] = col < row ? acc1[r] : 0.f; Lf[row * 64 + col] = acc1[r]; }
              st_n<0>(SL(0), m0, n0, lane, acc1);
              if (MODE >= 1) st_n<2>(SL(9), m0, n0, lane, acc2); }
          __syncthreads(); }
        if (w == 0) {
            unsigned char* Tn = SL(3); unsigned char* Tt = SL(2);
            { const int bi = lane >> 4, cc = lane & 15; float tc[16];
#pragma unroll
              for (int t = 0; t < 16; ++t) { float v = (t == cc) ? 1.0f : 0.0f;
#pragma unroll
                  for (int jx = 0; jx < t; ++jx) v += Lf[(16 * bi + t) * 64 + 16 * bi + jx] * tc[jx];
                  tc[t] = v; *(unsigned short*)(Tn + ((16 * bi + t) * LDP + 16 * bi + cc) * 2) = f2bf(v); asm volatile("" ::: "memory"); }
              *(u32x4*)(Tt + ((16 * bi + cc) * LDP + 16 * bi) * 2) = pack8(tc); *(u32x4*)(Tt + ((16 * bi + cc) * LDP + 16 * bi + 8) * 2) = pack8(tc + 8); }
            asm volatile("s_waitcnt lgkmcnt(0)" ::: "memory");
            const int pr = l32 >> 4, i16 = l32 & 15;
            {
              const bf16x8 a1 = *(const bf16x8*)(SL(0) + ((32 * pr + 16 + i16) * LDP + 32 * pr + 8 * hi) * 2);
              const bf16x8 b1 = *(const bf16x8*)(Tt + ((32 * pr + i16) * LDP + 32 * pr + 8 * hi) * 2);
              f32x16 m1 = __builtin_amdgcn_mfma_f32_32x32x16_bf16(a1, b1, zero16(), 0, 0, 0);
#pragma unroll
              for (int g = 0; g < 4; ++g) { const int row = 8 * g + 4 * hi; u32x2 wv; wv.x = pk2(m1[4 * g], m1[4 * g + 1]); wv.y = pk2(m1[4 * g + 2], m1[4 * g + 3]); *(u32x2*)(SC + (l32 * 40 + row) * 2) = wv; }
              asm volatile("s_waitcnt lgkmcnt(0)" ::: "memory");
              const bf16x8 a2 = *(const bf16x8*)(Tn + ((32 * pr + 16 + i16) * LDP + 32 * pr + 16 + 8 * hi) * 2);
              const bf16x8 b2 = *(const bf16x8*)(SC + (l32 * 40 + 16 * pr + 8 * hi) * 2);
              f32x16 t1 = __builtin_amdgcn_mfma_f32_32x32x16_bf16(a2, b2, zero16(), 0, 0, 0);
#pragma unroll
              for (int r = 0; r < 16; ++r) { const int row = crow(r, hi); if ((row >> 4) == pr) { const unsigned short hv = f2bf(t1[r]);
                  *(unsigned short*)(Tn + ((32 * pr + 16 + (row & 15)) * LDP + 32 * pr + i16) * 2) = hv; *(unsigned short*)(Tt + ((32 * pr + i16) * LDP + 32 * pr + 16 + (row & 15)) * 2) = hv; } }
              asm volatile("s_waitcnt lgkmcnt(0)" ::: "memory"); }
            {
              f32x16 m2 = zero16();
#pragma unroll
              for (int s = 0; s < 2; ++s) { const bf16x8 a = *(const bf16x8*)(SL(0) + ((32 + l32) * LDP + 16 * s + 8 * hi) * 2); const bf16x8 b = *(const bf16x8*)(Tt + (l32 * LDP + 16 * s + 8 * hi) * 2);
                  m2 = __builtin_amdgcn_mfma_f32_32x32x16_bf16(a, b, m2, 0, 0, 0); }
#pragma unroll
              for (int g = 0; g < 4; ++g) { const int row = 8 * g + 4 * hi; u32x2 wv; wv.x = pk2(m2[4 * g], m2[4 * g + 1]); wv.y = pk2(m2[4 * g + 2], m2[4 * g + 3]); *(u32x2*)(SC + (l32 * 40 + row) * 2) = wv; }
              asm volatile("s_waitcnt lgkmcnt(0)" ::: "memory");
              f32x16 t2 = zero16();
#pragma unroll
              for (int s = 0; s < 2; ++s) { const bf16x8 a = *(const bf16x8*)(Tn + ((32 + l32) * LDP + 32 + 16 * s + 8 * hi) * 2); const bf16x8 b = *(const bf16x8*)(SC + (l32 * 40 + 16 * s + 8 * hi) * 2);
                  t2 = __builtin_amdgcn_mfma_f32_32x32x16_bf16(a, b, t2, 0, 0, 0); }
#pragma unroll
              for (int r = 0; r < 16; ++r) *(unsigned short*)(Tn + ((32 + crow(r, hi)) * LDP + l32) * 2) = f2bf(t2[r]); }
        }
        __syncthreads();
        { bf16x8 fa[4], fb[4];
          if (w < 4) { ldf(SL(3), m0, lane, fa); ldf(SL(4), n0, lane, fb); } else { ldf(SL(8), m0, lane, fa); ldf(SL(5), n0, lane, fb); }
          __syncthreads();
          f32x16 acc = zero16(); mma4(acc, fa, fb);
          st_t<0>(w < 4 ? SL(4) : SL(8), m0, n0, lane, acc);
          __syncthreads(); }
        { bf16x8 fa[4], fb[4];
          if (w < 4) { ldf(SL(3), m0, lane, fa); ldf(SL(8), n0, lane, fb); }
          __syncthreads();
          if (w < 4) { f32x16 acc = zero16(); mma4(acc, fa, fb); st_t<0>(SL(8), m0, n0, lane, acc); }
          __syncthreads(); }
        if (MODE != 1) {
            bf16x8 fa[4], fb[4]; f32x16 acc = zero16();
            if (w < 4) { ldf(SL(4), m0, lane, fa); ldf(SL(6), n0, lane, fb); mma4(acc, fa, fb);
                bf16_t* PT = (bf16_t*)(ws + WS_PT) + (size_t)ci * 4096; const int col = n0 + l32;
#pragma unroll
                for (int g = 0; g < 4; ++g) { const int row = m0 + 8 * g + 4 * hi; float o[4];
#pragma unroll
                    for (int e = 0; e < 4; ++e) o[e] = acc[4 * g + e] + ((row + e) == col ? gC[col] : 0.f);
                    u32x2 wv; wv.x = pk2(o[0], o[1]); wv.y = pk2(o[2], o[3]); *(u32x2*)(PT + col * 64 + row) = wv; }
            } else { ldf(SL(8), m0, lane, fa); ldf(SL(6), n0, lane, fb); mma4(acc, fa, fb); ldf(SL(5), m0, lane, fa); ldf(SL(7), n0, lane, fb); mma4(acc, fa, fb);
                bf16_t* LC = (bf16_t*)(ws + WS_LC) + (size_t)ci * 4096 + (q * 64 + lane) * 16; float o[16];
#pragma unroll
                for (int r = 0; r < 16; ++r) o[r] = acc[r];
                *(u32x4*)LC = pack8(o); *(u32x4*)(LC + 8) = pack8(o + 8); }
            __syncthreads();
        }
        if (MODE == 1) {
            bf16x8 fa[4], fb[4]; f32x16 acc = zero16();
            if (w < 4) { ldf(SL(9), m0, lane, fa); ldf(SL(4), n0, lane, fb);
#pragma unroll
                for (int r = 0; r < 16; ++r) acc[r] = bf2f(*(const unsigned short*)(SL(1) + ((m0 + crow(r, hi)) * LDP + n0 + l32) * 2));
                mma4(acc, fa, fb); st_n<0>(SL(1), m0, n0, lane, acc);
            } else {
                ldf(SL(9), m0, lane, fa); ldf(SL(8), n0, lane, fb); mma4(acc, fa, fb);
                ldf(SL(10), m0, lane, fa); ldf(SL(5), n0, lane, fb); mma4(acc, fa, fb);
            }
            __syncthreads();
            if (w >= 4) {
                ldf(SL(1), m0, lane, fa); ldf_g((const bf16_t*)(ws + WS_LC) + (size_t)ci * 4096, n0, lane, fb); mma4(acc, fa, fb);

                bf16_t* Yg = (bf16_t*)(ws + (dir ? WS_YB : WS_YF));
#pragma unroll
                for (int r = 0; r < 16; ++r) { const int step = 64 * c + m0 + crow(r, hi); Yg[(tb + (size_t)(dir ? (SEQ - 1 - step) : step)) * 512 + colbase + n0 + l32] = f2bf(acc[r]); } }
            __syncthreads();
        }
        if (MODE == 2) {
            bf16x8 fa[4], fb[4]; f32x16 acc = zero16();
            if (w < 4) { ldf(SL(9), m0, lane, fa); ldf(SL(4), n0, lane, fb);
#pragma unroll
                for (int r = 0; r < 16; ++r) acc[r] = bf2f(*(const unsigned short*)(SL(1) + ((m0 + crow(r, hi)) * LDP + n0 + l32) * 2));
                mma4(acc, fa, fb);
                unsigned char* RPb = ws + (dir ? WS_WBK : WS_WF);
#pragma unroll
                for (int r = 0; r < 16; ++r) { const int step = 64 * c + m0 + crow(r, hi); *(unsigned short*)(RPb + ((tb + (size_t)(dir ? (SEQ - 1 - step) : step)) * 512 + colbase) * 4 + (n0 + l32) * 2) = f2bf(acc[r]); }
            } else { ldf(SL(9), m0, lane, fa); ldf(SL(8), n0, lane, fb); mma4(acc, fa, fb); ldf(SL(10), m0, lane, fa); ldf(SL(5), n0, lane, fb); mma4(acc, fa, fb);
                bf16_t* Yg = (bf16_t*)(ws + (dir ? WS_YB : WS_YF));
#pragma unroll
                for (int r = 0; r < 16; ++r) { const int step = 64 * c + m0 + crow(r, hi); Yg[(tb + (size_t)(dir ? (SEQ - 1 - step) : step)) * 512 + colbase + n0 + l32] = f2bf(acc[r]); } }
            __syncthreads();
        }
    }
#undef SL
}

__device__ void chunk_out_pass(unsigned char* ws) {
    const int tid = tid_opaque(), w = __builtin_amdgcn_readfirstlane(tid >> 6), lane = tid & 63, hi = lane >> 5, l32 = lane & 31;
    const int q = w & 3, m0 = (q >> 1) * 32, n0 = (q & 1) * 32, half = w >> 2;
    for (int ci = bid_opaque() * 2 + half; ci < 4096; ci += 2 * (int)gridDim.x) {
        const int inst = ci >> 7, c = ci & 127, b = inst >> 4, h = (inst >> 1) & 7, dir = inst & 1;
        const size_t tb = (size_t)b * SEQ; const int colbase = h * 64;
        const unsigned char* RPb = ws + (dir ? WS_WBK : WS_WF); bf16_t* Yg = (bf16_t*)(ws + (dir ? WS_YB : WS_YF));
        bf16x8 fa[4], fb[4]; f32x16 acc;
        { const int step = 64 * c + m0 + l32; const unsigned char* p = RPb + ((tb + (size_t)(dir ? (SEQ - 1 - step) : step)) * 512 + colbase) * 4 + 16 * hi;
#pragma unroll
          for (int s = 0; s < 4; ++s) fa[s] = *(const bf16x8*)(p + 32 * s); }
        ldf_g((const bf16_t*)(ws + WS_LC) + (size_t)ci * 4096, n0, lane, fb);
#pragma unroll
        for (int r = 0; r < 16; ++r) { const int step = 64 * c + m0 + crow(r, hi); acc[r] = bf2f(Yg[(tb + (size_t)(dir ? (SEQ - 1 - step) : step)) * 512 + colbase + n0 + l32]); }
        mma4(acc, fa, fb);
#pragma unroll
        for (int r = 0; r < 16; ++r) { const int step = 64 * c + m0 + crow(r, hi); Yg[(tb + (size_t)(dir ? (SEQ - 1 - step) : step)) * 512 + colbase + n0 + l32] = f2bf(acc[r]); }
    }
}
__device__ void chain_pass(unsigned char* lds, unsigned char* ws, int inst) {
    const int tid = tid_opaque(), w = __builtin_amdgcn_readfirstlane(tid >> 6), lane = tid & 63, hi = lane >> 5, l32 = lane & 31;
    const int q = w & 3, m0 = (q >> 1) * 32, n0 = (q & 1) * 32;
    unsigned char* Shi = lds; unsigned char* Slo = lds + SLOT;
    f32x16 S = zero16();
    bf16x8 fpA[4], fpB[4]; u32x4 lcA0 = (u32x4){0u, 0u, 0u, 0u}, lcA1 = lcA0, lcB0 = lcA0, lcB1 = lcA0;
    const bf16_t* PTb = (const bf16_t*)(ws + WS_PT) + (size_t)inst * 128 * 4096; bf16_t* LCb = (bf16_t*)(ws + WS_LC) + (size_t)inst * 128 * 4096;
#define CH_PREF(FP, L0, L1, cc) do { ldf_g(PTb + (size_t)(cc) * 4096, n0, lane, FP); const bf16_t* LC_ = LCb + (size_t)(cc) * 4096 + (q * 64 + lane) * 16; L0 = *(const u32x4*)LC_; L1 = *(const u32x4*)(LC_ + 8); } while (0)
#define CH_STEP(FP, L0, L1, FPN, LN0, LN1, cc) do { \
        if (w < 4) { const int col = n0 + l32; \
            _Pragma("unroll") for (int r = 0; r < 16; ++r) { const int row = m0 + crow(r, hi); const unsigned short hb = f2bf(S[r]); const float lo = S[r] - bf2f(hb); \
                *(unsigned short*)(Shi + (row * LDP + col) * 2) = hb; *(unsigned short*)(Slo + (row * LDP + col) * 2) = f2bf(lo); } \
            asm volatile("s_waitcnt vmcnt(0)" ::: "memory");     } \
        __syncthreads(); \
        if (w >= 4) { bf16_t* S0 = LCb + (size_t)(cc) * 4096; const int t2 = tid - 256; \
            _Pragma("unroll") for (int e = 0; e < 2; ++e) { const int idx = t2 + 256 * e, row = idx >> 3, kc = (idx & 7) * 8; *(u32x4*)(S0 + row * 64 + kc) = *(const u32x4*)(Shi + (row * LDP + kc) * 2); } \
        } else { \
            if ((cc) + 1 < 128) CH_PREF(FPN, LN0, LN1, (cc) + 1); \
            bf16x8 fa[4], fl[4]; f32x16 acc, acc2 = zero16(); float lcv[16]; unpack8(L0, lcv); unpack8(L1, lcv + 8); \
            _Pragma("unroll") for (int r = 0; r < 16; ++r) acc[r] = lcv[r]; \
            ldf(Shi, m0, lane, fa); ldf(Slo, m0, lane, fl); \
            _Pragma("unroll") for (int s = 0; s < 4; ++s) { acc = __builtin_amdgcn_mfma_f32_32x32x16_bf16(fa[s], FP[s], acc, 0, 0, 0); acc2 = __builtin_amdgcn_mfma_f32_32x32x16_bf16(fl[s], FP[s], acc2, 0, 0, 0); } \
            S = acc + acc2; } \
        __syncthreads(); } while (0)
    if (w < 4) CH_PREF(fpA, lcA0, lcA1, 0);
    __syncthreads();
    for (int c = 0; c < 128; c += 2) {
        CH_STEP(fpA, lcA0, lcA1, fpB, lcB0, lcB1, c);
        CH_STEP(fpB, lcB0, lcB1, fpA, lcA0, lcA1, c + 1);
    }
#undef CH_PREF
#undef CH_STEP
}
}
namespace att {
constexpr int NW = 8, QBLK = 32, KVBLK = 64, LDQ = 1536;
constexpr float THR = 8.0f;
constexpr size_t SHM_V = KVBLK * 128 * 2, SHM_K = KVBLK * 64 * 2, SHM_ATTN = 2 * SHM_V + 2 * SHM_K + NW * 64 * 4;
#define KSWZ(row, colB) ((row) * 128 + ((colB) ^ (((row) & 7) << 4)))
#define SBAR() __builtin_amdgcn_sched_barrier(0)
__device__ __forceinline__ int crow(int r, int hi) { return (r & 3) + 8 * (r >> 2) + 4 * hi; }
__device__ __forceinline__ unsigned cvtpk(float lo, float hi) { unsigned r; asm volatile("v_cvt_pk_bf16_f32 %0, %1, %2" : "=v"(r) : "v"(lo), "v"(hi)); return r; }
__device__ __forceinline__ void partialSM(f32x16& p0, f32x16& p1, float& m_reg, float& mn, float& alpha, float dq, float slope2, int hi) {
    const float d0 = dq - (float)(4 * hi);
#pragma unroll
    for (int r = 0; r < 16; ++r) { const float c = (float)((r & 3) + 8 * (r >> 2)); p0[r] = fmaf(-slope2, fabsf(d0 - c), p0[r]); p1[r] = fmaf(-slope2, fabsf(d0 - c - 32.0f), p1[r]); }
    float pmax = p0[0];
#pragma unroll
    for (int r = 1; r < 16; ++r) pmax = fmaxf(pmax, p0[r]);
#pragma unroll
    for (int r = 0; r < 16; ++r) pmax = fmaxf(pmax, p1[r]);
    { auto rr = __builtin_amdgcn_permlane32_swap(__float_as_uint(pmax), __float_as_uint(pmax), false, false); pmax = fmaxf(__uint_as_float(rr[0]), __uint_as_float(rr[1])); }
    if (__builtin_expect(__all(pmax - m_reg <= THR), 1)) { mn = m_reg; alpha = 1.f; }
    else { mn = fmaxf(m_reg, pmax); alpha = __builtin_amdgcn_exp2f(m_reg - mn); m_reg = mn; }
#pragma unroll
    for (int r = 0; r < 16; ++r) { p0[r] = p0[r] - mn; p1[r] = p1[r] - mn; }
#pragma unroll
    for (int r = 0; r < 16; ++r) p0[r] = __builtin_amdgcn_exp2f(p0[r]);
}
__device__ __forceinline__ void finishSM(f32x16& p0, f32x16& p1, float alpha, float& l_reg, bf16x8& pa0, bf16x8& pa1, bf16x8& pa2, bf16x8& pa3) {
#pragma unroll
    for (int r = 0; r < 16; ++r) p1[r] = __builtin_amdgcn_exp2f(p1[r]);
    float ps = 0;
#pragma unroll
    for (int r = 0; r < 16; ++r) ps += p0[r];
#pragma unroll
    for (int r = 0; r < 16; ++r) ps += p1[r];
    { auto rr = __builtin_amdgcn_permlane32_swap(__float_as_uint(ps), __float_as_uint(ps), false, false); ps = __uint_as_float(rr[0]) + __uint_as_float(rr[1]); }
    l_reg = l_reg * alpha + ps;
#define PK4(P, BASE, OUT) do { unsigned a0 = cvtpk(P[BASE + 0], P[BASE + 1]), a1 = cvtpk(P[BASE + 2], P[BASE + 3]);   \
    unsigned b0 = cvtpk(P[BASE + 4], P[BASE + 5]), b1 = cvtpk(P[BASE + 6], P[BASE + 7]);                              \
    auto r0 = __builtin_amdgcn_permlane32_swap(a0, b0, false, false); auto r1 = __builtin_amdgcn_permlane32_swap(a1, b1, false, false); \
    u32x4 w = {r0[0], r1[0], r0[1], r1[1]}; OUT = *reinterpret_cast<bf16x8*>(&w); } while (0)
    PK4(p0, 0, pa0); PK4(p0, 8, pa1); PK4(p1, 0, pa2); PK4(p1, 8, pa3);
#undef PK4
}
__device__ __forceinline__ void qkt(f32x16& p0, f32x16& p1, const char* Ks, const bf16x8* qr, int r32, int hi) {
    p0 = f32x16{}; p1 = f32x16{};
#pragma unroll
    for (int d0 = 0; d0 < 4; ++d0) { const int cb = (d0 * 16 + hi * 8) * 2;
        const bf16x8 b0 = *reinterpret_cast<const bf16x8*>(Ks + KSWZ(r32, cb));
        const bf16x8 b1 = *reinterpret_cast<const bf16x8*>(Ks + KSWZ(32 + r32, cb));
        p0 = __builtin_amdgcn_mfma_f32_32x32x16_bf16(b0, qr[d0], p0, 0, 0, 0);
        p1 = __builtin_amdgcn_mfma_f32_32x32x16_bf16(b1, qr[d0], p1, 0, 0, 0); }
}
__device__ __forceinline__ int v_st(int k, int c) { const int kk = (k & ~0xC) | ((k & 4) << 1) | ((k & 8) >> 1); return ((kk >> 3) * 4 + (c >> 5)) * 512 + ((kk & 7) * 32 + (c & 31)) * 2; }
__device__ __forceinline__ int v_rd_base(int lane) { return ((lane & 3) << 3) | (((lane >> 2) & 3) << 6) | (((lane >> 4) & 1) << 5) | (((lane >> 5) & 1) << 8); }
constexpr int v_rd_off(int d0, int ks, int half) { return d0 * 512 + ks * 4096 + half * 2048; }
template <int OFF> __device__ __forceinline__ s16x4 tr_read(int vb) { s16x4 r; asm volatile("ds_read_b64_tr_b16 %0, %1 offset:%2" : "=&v"(r) : "v"(vb), "i"(OFF) : "memory"); return r; }
template <int D0> __device__ __forceinline__ void pv_one(f32x16& od, int vb, bf16x8 pa0, bf16x8 pa1, bf16x8 pa2, bf16x8 pa3) {
    const s16x4 l0 = tr_read<v_rd_off(D0, 0, 0)>(vb), h0 = tr_read<v_rd_off(D0, 0, 1)>(vb), l1 = tr_read<v_rd_off(D0, 1, 0)>(vb), h1 = tr_read<v_rd_off(D0, 1, 1)>(vb);
    const s16x4 l2 = tr_read<v_rd_off(D0, 2, 0)>(vb), h2 = tr_read<v_rd_off(D0, 2, 1)>(vb), l3 = tr_read<v_rd_off(D0, 3, 0)>(vb), h3 = tr_read<v_rd_off(D0, 3, 1)>(vb);
    asm volatile("s_waitcnt lgkmcnt(0)" ::: "memory"); SBAR();
#define PK(L, H) (bf16x8){L[0], L[1], L[2], L[3], H[0], H[1], H[2], H[3]}
    od = __builtin_amdgcn_mfma_f32_32x32x16_bf16(pa0, PK(l0, h0), od, 0, 0, 0);
    od = __builtin_amdgcn_mfma_f32_32x32x16_bf16(pa1, PK(l1, h1), od, 0, 0, 0);
    od = __builtin_amdgcn_mfma_f32_32x32x16_bf16(pa2, PK(l2, h2), od, 0, 0, 0);
    od = __builtin_amdgcn_mfma_f32_32x32x16_bf16(pa3, PK(l3, h3), od, 0, 0, 0);
#undef PK
}
__device__ __forceinline__ void pv_d0(f32x16* o, int vb, bf16x8 pa0, bf16x8 pa1, bf16x8 pa2, bf16x8 pa3) {
    pv_one<0>(o[0], vb, pa0, pa1, pa2, pa3); pv_one<1>(o[1], vb, pa0, pa1, pa2, pa3); pv_one<2>(o[2], vb, pa0, pa1, pa2, pa3); pv_one<3>(o[3], vb, pa0, pa1, pa2, pa3);
}
__device__ __forceinline__ void attn_unit(const bf16_t* __restrict__ Qb, const bf16_t* __restrict__ Kh, const bf16_t* __restrict__ Vh, bf16_t* __restrict__ Ob, int qpos0, float slope2, char* lds, const int NT) {
    const int tid = tid_opaque(), wid = tid >> 6, lane = tid & 63, r32 = lane & 31, hi = lane >> 5;
    char* V_lds = lds; char* K_lds = lds + 2 * SHM_V;
    float* wsf = (float*)(lds + 2 * SHM_V + 2 * SHM_K) + wid * 64; float* li_l = wsf; float* al_l = wsf + 32;
    float m_reg = -1e30f, l_reg = 0; f32x16 o[4] = {}; bf16x8 qr[4];
    const bf16_t* Qw = Qb + (size_t)(wid * QBLK + r32) * LDQ + hi * 8;
#pragma unroll
    for (int d0 = 0; d0 < 4; ++d0) qr[d0] = *reinterpret_cast<const bf16x8*>(Qw + d0 * 16);
    const float qposf = (float)(qpos0 + wid * QBLK + r32);
    const int sr = tid >> 4, sc = (tid & 15) * 8, vst0 = v_st(sr, sc), vst1 = v_st(32 + sr, sc);
    const int kr = tid >> 3, kc = (tid & 7) * 8, kst = KSWZ(kr, kc * 2);
    const int vb0 = (int)(uintptr_t)V_lds + v_rd_base(lane);
    bf16x8 sv0[2], sv1[2], sk0[2];
#define SLOAD(i, k0) do { sv0[i] = *reinterpret_cast<const bf16x8*>(&Vh[(size_t)((k0) + sr) * LDQ + sc]); sv1[i] = *reinterpret_cast<const bf16x8*>(&Vh[(size_t)((k0) + 32 + sr) * LDQ + sc]); \
    sk0[i] = *reinterpret_cast<const bf16x8*>(&Kh[(size_t)((k0) + kr) * LDQ + kc]); } while (0)
#define SWRITE(b, i) do { *(bf16x8*)(V_lds + (b) * SHM_V + vst0) = sv0[i]; *(bf16x8*)(V_lds + (b) * SHM_V + vst1) = sv1[i]; *(bf16x8*)(K_lds + (b) * SHM_K + kst) = sk0[i]; } while (0)
#define SWAIT() asm volatile("s_waitcnt vmcnt(3)" ::: "memory")
#define RESC(a) do { if (__any((a) < 1.f)) { if (hi == 0) al_l[r32] = (a); asm volatile("s_waitcnt lgkmcnt(0)" ::: "memory"); \
    _Pragma("unroll") for (int d = 0; d < 4; ++d) _Pragma("unroll") for (int r = 0; r < 16; ++r) o[d][r] *= al_l[crow(r, hi)]; } } while (0)
    f32x16 pA0, pA1, pB0, pB1; float mnA, mnB, alA, alB; bf16x8 pa0, pa1, pa2, pa3;
    __syncthreads();
    SLOAD(0, 0); asm volatile("s_waitcnt vmcnt(0)" ::: "memory"); SWRITE(0, 0); __syncthreads();
    qkt(pA0, pA1, K_lds, qr, r32, hi); partialSM(pA0, pA1, m_reg, mnA, alA, qposf, slope2, hi);
    SLOAD(1, KVBLK); if (2 < NT) SLOAD(0, 2 * KVBLK);
    SWAIT(); SWRITE(1, 1); __syncthreads();
    for (int j = 1; j + 1 < NT; j += 2) {
        SBAR(); qkt(pB0, pB1, K_lds + SHM_K, qr, r32, hi);
        finishSM(pA0, pA1, alA, l_reg, pa0, pa1, pa2, pa3); SBAR();
        SLOAD(1, (j + 2) * KVBLK); SBAR();
        pv_d0(o, vb0, pa0, pa1, pa2, pa3); partialSM(pB0, pB1, m_reg, mnB, alB, qposf - (float)(j * KVBLK), slope2, hi);
        __syncthreads(); SWAIT(); SWRITE(0, 0);
        RESC(alB); __syncthreads();
        SBAR(); qkt(pA0, pA1, K_lds, qr, r32, hi);
        finishSM(pB0, pB1, alB, l_reg, pa0, pa1, pa2, pa3); SBAR();
        if (j + 3 < NT) SLOAD(0, (j + 3) * KVBLK); SBAR();
        pv_d0(o, vb0 + (int)SHM_V, pa0, pa1, pa2, pa3); partialSM(pA0, pA1, m_reg, mnA, alA, qposf - (float)((j + 1) * KVBLK), slope2, hi);
        __syncthreads(); SWAIT(); SWRITE(1, 1);
        RESC(alA); __syncthreads();
    }
    SBAR(); qkt(pB0, pB1, K_lds + SHM_K, qr, r32, hi);
    finishSM(pA0, pA1, alA, l_reg, pa0, pa1, pa2, pa3); SBAR();
    pv_d0(o, vb0, pa0, pa1, pa2, pa3); partialSM(pB0, pB1, m_reg, mnB, alB, qposf - (float)((NT - 1) * KVBLK), slope2, hi);
    __syncthreads(); RESC(alB);
    finishSM(pB0, pB1, alB, l_reg, pa0, pa1, pa2, pa3); SBAR();
    pv_d0(o, vb0 + (int)SHM_V, pa0, pa1, pa2, pa3);
    if (hi == 0) li_l[r32] = l_reg; asm volatile("s_waitcnt lgkmcnt(0)" ::: "memory");
    float rli[16];
#pragma unroll
    for (int r = 0; r < 16; ++r) rli[r] = __builtin_amdgcn_rcpf(li_l[crow(r, hi)]);
    bf16_t* Ow = Ob + (size_t)(wid * QBLK) * 512;
#pragma unroll
    for (int r = 0; r < 16; ++r) { const int orow = crow(r, hi);
#pragma unroll
        for (int d0 = 0; d0 < 4; ++d0) Ow[(size_t)orow * 512 + d0 * 32 + r32] = (bf16_t)(cvtpk(o[d0][r] * rli[r], 0.f) & 0xffffu); }
#undef SLOAD
#undef SWRITE
#undef SWAIT
#undef RESC
}
}
#define XB_TMO      128
#define XB_XCNT(j)  (256  + 64 * (j))
#define XB_XSUB(j)  (1280 + 64 * (j))
#define XB_XGEN(j)  (2304 + 64 * (j))
#define XB_TOP      3328
#define XB_TOPGEN   3392
#define XCD_BAR_WORDS 3456
#define XB_SPIN_CAP (1u << 18)

__device__ __forceinline__ unsigned xb_ld(unsigned* p)              { return __hip_atomic_load(p, __ATOMIC_RELAXED, __HIP_MEMORY_SCOPE_AGENT); }
__device__ __forceinline__ unsigned xb_add(unsigned* p, unsigned v) { return __hip_atomic_fetch_add(p, v, __ATOMIC_RELAXED, __HIP_MEMORY_SCOPE_AGENT); }
__device__ __forceinline__ unsigned xb_xcc_id() { return (unsigned)__builtin_amdgcn_s_getreg((3 << 11) | 20) & 0xFu; }
#define XB_SPIN(cond, bar) do { unsigned _sp = 0; while (cond) { __builtin_amdgcn_s_sleep(1); \
    if ((++_sp & 255u) == 0u) { if (xb_ld(&(bar)[XB_TMO])) break; if (_sp > XB_SPIN_CAP) { atomicAdd(&(bar)[XB_TMO], 1u); break; } } } } while (0)

struct XcdBarrier {
    unsigned* bar; unsigned x;
    volatile LAS unsigned* st;
};

__device__ __forceinline__ XcdBarrier xcd_barrier_post(unsigned* bar, volatile LAS unsigned* st) {
    XcdBarrier b; b.bar = bar; b.x = xb_xcc_id(); b.st = st;
    if (threadIdx.x == 0) (void)xb_add(&bar[XB_XCNT(b.x)], 1u);
    return b;
}
__device__ __forceinline__ void xcd_barrier_complete(unsigned* bar, unsigned x, unsigned& nloc, unsigned& nx) {
    const unsigned G = gridDim.x * gridDim.y * gridDim.z;
    unsigned sum, cnt, mine, sp = 0u;
    for (;;) {
        sum = 0u; cnt = 0u; mine = 0u;
#pragma unroll
        for (unsigned j = 0; j < 16; ++j) { const unsigned c = xb_ld(&bar[XB_XCNT(j)]); sum += c; cnt += (c > 0u) ? 1u : 0u; mine = (j == x) ? c : mine; }
        if (sum == G) break;
        __builtin_amdgcn_s_sleep(1);
        if ((++sp & 255u) == 0u) { if (xb_ld(&bar[XB_TMO])) break; if (sp > XB_SPIN_CAP) { atomicAdd(&bar[XB_TMO], 1u); break; } }
    }
    nloc = mine > 0u ? mine : 1u; nx = cnt > 0u ? cnt : 1u;
}

__device__ __forceinline__ void xcd_barrier(const XcdBarrier& b) {
    asm volatile("s_waitcnt vmcnt(0)" ::: "memory");
    __syncthreads();
    if (threadIdx.x == 0) {
        unsigned* bar = b.bar;
        __builtin_amdgcn_s_waitcnt(0);
        unsigned nloc = b.st[0], nx = b.st[1];
        if (nloc == 0u) { xcd_barrier_complete(bar, b.x, nloc, nx); b.st[0] = nloc; b.st[1] = nx; }
        const unsigned old = xb_add(&bar[XB_XSUB(b.x)], 1u);
        const unsigned gen = old / nloc;
        if (old + 1u == (gen + 1u) * nloc) {
            __builtin_amdgcn_fence(__ATOMIC_RELEASE, "agent");
            asm volatile("s_waitcnt vmcnt(0)" ::: "memory");
            const unsigned og = xb_add(&bar[XB_TOP], 1u);
            const unsigned tg = og / nx;
            if (og + 1u == (tg + 1u) * nx) xb_add(&bar[XB_TOPGEN], 1u);
            else XB_SPIN(xb_ld(&bar[XB_TOPGEN]) == tg, bar);
            __builtin_amdgcn_fence(__ATOMIC_ACQUIRE, "agent");
            xb_add(&bar[XB_XGEN(b.x)], 1u);
            asm volatile("s_waitcnt vmcnt(0)" ::: "memory");
        } else {
            XB_SPIN(xb_ld(&bar[XB_XGEN(b.x)]) == gen, bar);
            __builtin_amdgcn_fence(__ATOMIC_ACQUIRE, "agent");
            asm volatile("s_waitcnt vmcnt(0)" ::: "memory");
        }
    }
    __syncthreads();
}

__device__ void mixer_phase(const Params& P, int l, unsigned char* smem) {
    unsigned char* ws = P.ws;
    const int bid = bid_opaque(); const int tid0 = tid_opaque();
    if (bid < 32) ck::chain_pass(smem, ws, bid);
    unsigned* ctr = (unsigned*)(ws + WS_CTL) + 64 * l;
    volatile unsigned* slot = (volatile unsigned*)(smem + 131072);
    const bf16_t* QKV = (const bf16_t*)(ws + WS_QKV);
    float gq = fabsf(P.in[17][l * 64 + (tid0 & 63)]), gk = fabsf(P.in[18][l * 64 + (tid0 & 63)]);
#pragma unroll
    for (int o = 32; o > 0; o >>= 1) { gq = fmaxf(gq, __shfl_xor(gq, o)); gk = fmaxf(gk, __shfl_xor(gk, o)); }
    const float smax2 = 2.0f * 8.0f * LOG2E * gq * gk + 150.0f;
    for (;;) {
        __syncthreads();
        if (tid0 == 0) slot[0] = atomicAdd(ctr, 1u);
        __syncthreads();
        const unsigned u = slot[0];
        if (u >= 512u) {
            const unsigned bt = u - 512u; if (bt >= (unsigned)(CVT_FFN_TILES / 8)) break;
            for (int t8 = 0; t8 < 8; ++t8) cvt_ffn_tile(smem, ws, P.in[24] + (size_t)l * DM * NFF, P.in[25] + (size_t)l * DFF * DM, (int)bt * 8 + t8, tid0);
            continue; }
        const int qb = u & 31, rest = u >> 5, map = rest & 1, b = (rest >> 1) & 1, h = 3 - (rest >> 2);
        const size_t row0 = (size_t)b * SEQ + (size_t)qb * 256;
        const float slope2 = exp2f(-2.0f * (float)(h + 1)) * LOG2E;
        const int W = (int)fminf(smax2 / slope2, 16384.0f) + 1;
        int jlo = (qb * 256 - W) >> 6; if (jlo < 0) jlo = 0;
        int jhi = ((qb * 256 + 255 + W) >> 6) + 1; if (jhi > SEQ / 64) jhi = SEQ / 64;
        if ((jhi - jlo) & 1) { if (jlo > 0) --jlo; else ++jhi; }
        bf16_t* Ob = (bf16_t*)(ws + (map ? WS_O1 : WS_O0)) + row0 * 512 + h * 128;
        const bf16_t* Kb0 = QKV + ((size_t)b * SEQ + (size_t)jlo * 64) * 1536;
        att::attn_unit(QKV + row0 * 1536 + h * 128 + map * 64, Kb0 + 512 + h * 128 + map * 64, Kb0 + 1024 + h * 128, Ob, qb * 256 - jlo * 64, slope2, (char*)smem, jhi - jlo);
    }
}
__device__ void post_phase(const Params& P, int l) {
    unsigned char* ws = P.ws;
    const bf16_t* YF = (const bf16_t*)(ws + WS_YF); const bf16_t* YB = (const bf16_t*)(ws + WS_YB); const bf16_t* R = (const bf16_t*)(ws + WS_R); const bf16_t* V = (const bf16_t*)(ws + WS_V);
    const bf16_t* AF = (const bf16_t*)(ws + WS_AF); const bf16_t* AB = (const bf16_t*)(ws + WS_AB); const bf16_t* Kb = (const bf16_t*)(ws + WS_K); const float* k_a = P.in[13] + l * 512; const bf16_t* GATE = (const bf16_t*)(ws + WS_GATE);
    const bf16_t* O0 = (const bf16_t*)(ws + WS_O0); const bf16_t* O1 = (const bf16_t*)(ws + WS_O1); bf16_t* AO = (bf16_t*)(ws + WS_AO);
    const float* r_k = P.in[14] + l * 512; const float* lng = P.in[15] + l * 512; const float* lnb = P.in[16] + l * 512; const float* lamv = P.in[19] + l * 256; const float* subg = P.in[20] + l * 128;
    const int tid_ = tid_opaque(); const int lane = tid_ & 63, gw = bid_opaque() * 8 + (tid_ >> 6), nw = gridDim.x * 8;
    const float lam_init = 0.8f - 0.6f * expf(-0.3f * (float)l);
    const float s1 = wave_sum(lamv[lane] * lamv[64 + lane]), s2 = wave_sum(lamv[128 + lane] * lamv[192 + lane]);
    const float lam = expf(s1) - expf(s2) + lam_init;
    const int c0 = 8 * lane;
    const f32x4 ka0 = *(const f32x4*)(k_a + c0), ka1 = *(const f32x4*)(k_a + c0 + 4); const f32x4 rk0 = *(const f32x4*)(r_k + c0), rk1 = *(const f32x4*)(r_k + c0 + 4), lg0 = *(const f32x4*)(lng + c0), lg1 = *(const f32x4*)(lng + c0 + 4), lb0 = *(const f32x4*)(lnb + c0), lb1 = *(const f32x4*)(lnb + c0 + 4);
    const f32x4 sg0 = *(const f32x4*)(subg + (c0 & 127)), sg1 = *(const f32x4*)(subg + (c0 & 127) + 4);
    for (int tok = gw; tok < T; tok += nw) {
        const size_t off = (size_t)tok * 512 + c0;
        float yf[8], yb[8], r[8], v[8], kf[8], kb[8], kx[8], gt[8], y[8], o[8];
        unpack8(*(const u32x4*)(YF + off), yf); unpack8(*(const u32x4*)(YB + off), yb); unpack8(*(const u32x4*)(R + off), r); unpack8(*(const u32x4*)(V + off), v);
        unpack8(*(const u32x4*)(AF + off), kf); unpack8(*(const u32x4*)(AB + off), kb); unpack8(*(const u32x4*)(Kb + off), kx); unpack8(*(const u32x4*)(GATE + off), gt);
        float sm = 0.f, bs = 0.f;
#pragma unroll
        for (int j = 0; j < 8; ++j) { y[j] = yf[j] + yb[j]; sm += y[j]; bs += r[j] * kx[j] * (2.0f + (kf[j] + kb[j] - 2.0f) * (j < 4 ? ka0[j] : ka1[j - 4])) * (j < 4 ? rk0[j] : rk1[j - 4]); }
        sm += __shfl_xor(sm, 1); sm += __shfl_xor(sm, 2); sm += __shfl_xor(sm, 4); bs += __shfl_xor(bs, 1); bs += __shfl_xor(bs, 2); bs += __shfl_xor(bs, 4);
        const float mean = sm * (1.0f / 64.0f); float vs = 0.f;
#pragma unroll
        for (int j = 0; j < 8; ++j) { const float d = y[j] - mean; vs += d * d; }
        vs += __shfl_xor(vs, 1); vs += __shfl_xor(vs, 2); vs += __shfl_xor(vs, 4);
        const float rstd = rsqrtf(vs * (1.0f / 64.0f) + 64e-5f);
#pragma unroll
        for (int j = 0; j < 8; ++j) { const float g = j < 4 ? lg0[j] : lg1[j - 4], bb = j < 4 ? lb0[j] : lb1[j - 4]; o[j] = ((y[j] - mean) * rstd * g + bb + bs * v[j]) * gt[j]; }
        *(u32x4*)(AO + (size_t)tok * 1024 + c0) = pack8(o);
        float a0[8], a1[8], d[8]; unpack8(*(const u32x4*)(O0 + off), a0); unpack8(*(const u32x4*)(O1 + off), a1);
        float sq = 0.f;
#pragma unroll
        for (int j = 0; j < 8; ++j) { d[j] = a0[j] - lam * a1[j]; sq += d[j] * d[j]; }
        sq += __shfl_xor(sq, 1); sq += __shfl_xor(sq, 2); sq += __shfl_xor(sq, 4); sq += __shfl_xor(sq, 8);
        const float rs = rsqrtf(sq * (1.0f / 128.0f) + 1e-6f) * (1.0f - lam_init);
#pragma unroll
        for (int j = 0; j < 8; ++j) d[j] *= rs * (j < 4 ? sg0[j] : sg1[j - 4]);
        *(u32x4*)(AO + (size_t)tok * 1024 + 512 + c0) = pack8(d);
    }
}
__device__ void outpost_phase(const Params& P, int l, unsigned char* smem) {
    unsigned char* ws = P.ws;
    const bf16_t* YF = (const bf16_t*)(ws + WS_YF); const bf16_t* YB = (const bf16_t*)(ws + WS_YB); const bf16_t* R = (const bf16_t*)(ws + WS_R); const bf16_t* V = (const bf16_t*)(ws + WS_V);
    const bf16_t* AF = (const bf16_t*)(ws + WS_AF); const bf16_t* AB = (const bf16_t*)(ws + WS_AB); const bf16_t* Kb = (const bf16_t*)(ws + WS_K); const float* k_a = P.in[13] + l * 512; const bf16_t* GATE = (const bf16_t*)(ws + WS_GATE);
    const bf16_t* O0 = (const bf16_t*)(ws + WS_O0); const bf16_t* O1 = (const bf16_t*)(ws + WS_O1); bf16_t* AO = (bf16_t*)(ws + WS_AO);
    const float* r_k = P.in[14] + l * 512; const float* lng = P.in[15] + l * 512; const float* lnb = P.in[16] + l * 512; const float* lamv = P.in[19] + l * 256; const float* subg = P.in[20] + l * 128;
    const int tid_ = tid_opaque(); const int lane = tid_ & 63, w = __builtin_amdgcn_readfirstlane(tid_ >> 6), hi = lane >> 5, l32 = lane & 31;
    float* Yb = (float*)smem;
    const float lam_init = 0.8f - 0.6f * expf(-0.3f * (float)l);
    const float s1 = wave_sum(lamv[lane] * lamv[64 + lane]), s2 = wave_sum(lamv[128 + lane] * lamv[192 + lane]);
    const float lam = expf(s1) - expf(s2) + lam_init;
    const int c0 = 8 * lane;
    const f32x4 ka0 = *(const f32x4*)(k_a + c0), ka1 = *(const f32x4*)(k_a + c0 + 4); const f32x4 rk0 = *(const f32x4*)(r_k + c0), rk1 = *(const f32x4*)(r_k + c0 + 4), lg0 = *(const f32x4*)(lng + c0), lg1 = *(const f32x4*)(lng + c0 + 4), lb0 = *(const f32x4*)(lnb + c0), lb1 = *(const f32x4*)(lnb + c0 + 4);
    const f32x4 sg0 = *(const f32x4*)(subg + (c0 & 127)), sg1 = *(const f32x4*)(subg + (c0 & 127) + 4);
    for (int blk = bid_opaque(); blk < 2 * (SEQ / 64); blk += (int)gridDim.x) {
      const int b = blk >> 7, tbk = blk & 127; const size_t tok0 = (size_t)b * SEQ + 64 * tbk;
      { const int h = w; const size_t cif = (size_t)(((b * 16 + h * 2) << 7) + tbk), cib = (size_t)(((b * 16 + h * 2 + 1) << 7) + (127 - tbk));
        const bf16_t* LCp = (const bf16_t*)(ws + WS_LC);
#pragma unroll 2
        for (int q = 0; q < 4; ++q) { const int m0 = (q >> 1) * 32, n0 = (q & 1) * 32; f32x16 acc; bf16x8 fa[4], fb[4];
#pragma unroll
            for (int r = 0; r < 16; ++r) { const size_t yo = (tok0 + m0 + ck::crow(r, hi)) * 512 + h * 64 + n0 + l32; acc[r] = bf2f(YF[yo]) + bf2f(YB[yo]); }
            { const unsigned char* p = ws + WS_WF + ((tok0 + m0 + l32) * 512 + h * 64) * 4 + 16 * hi;
#pragma unroll
              for (int s = 0; s < 4; ++s) fa[s] = *(const bf16x8*)(p + 32 * s); }
            ck::ldf_g(LCp + cif * 4096, n0, lane, fb); ck::mma4(acc, fa, fb);
            { const unsigned char* p = ws + WS_WBK + ((tok0 + m0 + l32) * 512 + h * 64) * 4 + 16 * hi;
#pragma unroll
              for (int s = 0; s < 4; ++s) fa[s] = *(const bf16x8*)(p + 32 * s); }
            ck::ldf_g(LCp + cib * 4096, n0, lane, fb); ck::mma4(acc, fa, fb);
#pragma unroll
            for (int r = 0; r < 16; ++r) Yb[(m0 + ck::crow(r, hi)) * 512 + h * 64 + n0 + l32] = acc[r]; } }
      __syncthreads();
#pragma unroll 2
      for (int ti = 0; ti < 8; ++ti) {
        const int tl = 8 * w + ti; const int tok = (int)tok0 + tl;
        const size_t off = (size_t)tok * 512 + c0;
        float r[8], v[8], kf[8], kb[8], kx[8], gt[8], y[8], o[8];
        { const f32x4 y0 = *(const f32x4*)(Yb + tl * 512 + c0), y1 = *(const f32x4*)(Yb + tl * 512 + c0 + 4); y[0] = y0[0]; y[1] = y0[1]; y[2] = y0[2]; y[3] = y0[3]; y[4] = y1[0]; y[5] = y1[1]; y[6] = y1[2]; y[7] = y1[3]; }
        unpack8(*(const u32x4*)(R + off), r); unpack8(*(const u32x4*)(V + off), v);
        unpack8(*(const u32x4*)(AF + off), kf); unpack8(*(const u32x4*)(AB + off), kb); unpack8(*(const u32x4*)(Kb + off), kx); unpack8(*(const u32x4*)(GATE + off), gt);
        float sm = 0.f, bs = 0.f;
#pragma unroll
        for (int j = 0; j < 8; ++j) { sm += y[j]; bs += r[j] * kx[j] * (2.0f + (kf[j] + kb[j] - 2.0f) * (j < 4 ? ka0[j] : ka1[j - 4])) * (j < 4 ? rk0[j] : rk1[j - 4]); }
        sm += __shfl_xor(sm, 1); sm += __shfl_xor(sm, 2); sm += __shfl_xor(sm, 4); bs += __shfl_xor(bs, 1); bs += __shfl_xor(bs, 2); bs += __shfl_xor(bs, 4);
        const float mean = sm * (1.0f / 64.0f); float vs = 0.f;
#pragma unroll
        for (int j = 0; j < 8; ++j) { const float d = y[j] - mean; vs += d * d; }
        vs += __shfl_xor(vs, 1); vs += __shfl_xor(vs, 2); vs += __shfl_xor(vs, 4);
        const float rstd = rsqrtf(vs * (1.0f / 64.0f) + 64e-5f);
#pragma unroll
        for (int j = 0; j < 8; ++j) { const float g = j < 4 ? lg0[j] : lg1[j - 4], bb = j < 4 ? lb0[j] : lb1[j - 4]; o[j] = ((y[j] - mean) * rstd * g + bb + bs * v[j]) * gt[j]; }
        *(u32x4*)(AO + (size_t)tok * 1024 + c0) = pack8(o);
        float a0[8], a1[8], d[8]; unpack8(*(const u32x4*)(O0 + off), a0); unpack8(*(const u32x4*)(O1 + off), a1);
        float sq = 0.f;
#pragma unroll
        for (int j = 0; j < 8; ++j) { d[j] = a0[j] - lam * a1[j]; sq += d[j] * d[j]; }
        sq += __shfl_xor(sq, 1); sq += __shfl_xor(sq, 2); sq += __shfl_xor(sq, 4); sq += __shfl_xor(sq, 8);
        const float rs = rsqrtf(sq * (1.0f / 128.0f) + 1e-6f) * (1.0f - lam_init);
#pragma unroll
        for (int j = 0; j < 8; ++j) d[j] *= rs * (j < 4 ? sg0[j] : sg1[j - 4]);
        *(u32x4*)(AO + (size_t)tok * 1024 + 512 + c0) = pack8(d);
      }
      __syncthreads();
    }
}
template <class Epi> __device__ __forceinline__ void run_gemm(unsigned char* smem, const bf16_t* A, const bf16_t* Bt, int N, int K, const Epi& E) {
    asm volatile("" : "+s"(K)); asm volatile("" : "+s"(N));
    pg8::Gemm g{A, Bt, T, N, K}; pg8::StaticOrder S; S.init(T, N, (int)gridDim.x, bid_opaque());
    pg8::gemm_phase<Epi, pg8::StaticOrder, true, true>((PG8_LAS unsigned char*)smem, g, S, E);
}
__global__ void __launch_bounds__(512, 2) mega_fwd(Params P) {
    extern __shared__ __attribute__((aligned(16))) unsigned char smem[];
    cg::grid_group grid = cg::this_grid();
    unsigned char* ws = P.ws;
    unsigned* barw = (unsigned*)(ws + WS_CTL) + 4096;
    volatile LAS unsigned* bst = (volatile LAS unsigned*)((LAS unsigned char*)smem + 131072 + 64);
    if (threadIdx.x < 2) bst[threadIdx.x] = 0u;
    if (P.ph_lo == 0 && blockIdx.x == 0) { if (threadIdx.x < DEPTH) ((unsigned*)(ws + WS_CTL))[64 * threadIdx.x] = 0u; for (int i = threadIdx.x; i < XCD_BAR_WORDS; i += 512) barw[i] = 0u; }
    __syncthreads();
    XcdBarrier xb; xb.bar = barw; xb.x = 0; xb.st = bst; bool posted = false;
    bf16_t* XN = (bf16_t*)(ws + WS_XN); bf16_t* H = (bf16_t*)(ws + WS_H); bf16_t* WA = (bf16_t*)(ws + WS_WA); bf16_t* WB = (bf16_t*)(ws + WS_WB);
    for (int ph = P.ph_lo; ph < P.ph_hi; ++ph) {
        const int l = ph / NPH, k = ph - l * NPH;
        const float* xcur = (l == 0 && k <= 2) ? P.in[0] : P.out;
#ifndef ONLY_K
#define ONLY_K -1
#endif
#ifndef REP_MASK
#define REP_MASK 0
#endif
        for (int rep = 0; rep < (((REP_MASK >> k) & 1) ? 2 : 1); ++rep)
        switch (ONLY_K >= 0 ? ONLY_K : k) {
        case 0: cvt_ffn(smem, ws, P.in[2] + (size_t)l * DM * NFF, P.in[3] + (size_t)l * DFF * DM); norm_rows(xcur, P.in[1] + l * DM, XN); break;
        case 1: case 13: { EpiSwiGLU E{H}; run_gemm(smem, XN, WA, NFF, DM, E); } break;
        case 2: { EpiResid E{xcur, P.out, 0.5f}; run_gemm(smem, H, WB, DM, DFF, E); } break;
        case 3: cvt_mixer(smem, ws, P.in[5] + (size_t)l * DM * CIN_SRC, P.in[8] + (size_t)l * 2 * 64 * 512, P.in[10] + (size_t)l * 2 * 64 * 512, P.in[11] + (size_t)l * 128 * 512,
                          P.in[21] + (size_t)l * 2 * 512 * DM, P.in[22] + (size_t)l * DM * DM);
                norm_rows(P.out, P.in[4] + l * DM, XN); break;
        case 4: { EpiWin E{(bf16_t*)(ws + WS_PR), (bf16_t*)(ws + WS_QKV), (bf16_t*)(ws + WS_G)}; run_gemm(smem, XN, WA, NWIN, DM, E); } break;
        case 5: prep_phase(P, l); break;
        case 6: { EpiDecay E1{P.in[7] + l * 1024, (float*)(ws + WS_WF), (float*)(ws + WS_WBK)}; run_gemm(smem, (const bf16_t*)(ws + WS_LIN), (const bf16_t*)(ws + WS_WL), 1024, KLORA, E1);
                  EpiIclr E2{P.in[9] + l * 1024, (bf16_t*)(ws + WS_AF), (bf16_t*)(ws + WS_AB), (bf16_t*)(ws + WS_GATE)}; run_gemm(smem, (const bf16_t*)(ws + WS_LIN), (const bf16_t*)(ws + WS_WL) + (size_t)1024 * KLORA, 1536, KLORA, E2); } break;
        case 7: ck::chunk_pass<2>(smem, ws, P.in[13] + l * 512); break;
        case 8: mixer_phase(P, l, smem); break;
        case 9: outpost_phase(P, l, smem); break;
        case 10: { EpiBranch E{(const bf16_t*)(ws + WS_G), XN}; run_gemm(smem, (const bf16_t*)(ws + WS_AO), (const bf16_t*)(ws + WS_WR), 2048, DM, E); } break;
        case 11: { EpiResid E{P.out, P.out, 1.0f}; run_gemm(smem, XN, (const bf16_t*)(ws + WS_WO), DM, DM, E); } break;
        case 12: norm_rows(P.out, P.in[23] + l * DM, XN); break;
        case 14: { EpiResid E{P.out, P.out, 0.5f}; run_gemm(smem, H, WB, DM, DFF, E); } break;
        default: break;
        }
        if (ph + 1 < P.ph_hi) {
            if (!posted) { grid.sync(); xb = xcd_barrier_post(barw, bst); posted = true; }
            else xcd_barrier(xb);
        }
    }
}
#ifndef MK_PER_PHASE
#define MK_PER_PHASE 0
#endif
extern "C" void kernel_launch(void* const* d_in, const int* in_sizes, int n_in, void* d_out, int out_size, void* d_ws, size_t ws_size, hipStream_t stream) {
    static int grid = 0;
    if (grid == 0) {
        if (n_in != 26 || out_size != T * DM || ws_size < WS_END) { fprintf(stderr, "kernel_launch: unexpected shapes: n_in %d out %d ws %zu (need %zu)\n", n_in, out_size, ws_size, (size_t)WS_END); grid = -1; return; }
        int dev = 0, cus = 0, per_cu = 0;
        hipGetDevice(&dev); hipDeviceGetAttribute(&cus, hipDeviceAttributeMultiprocessorCount, dev);
        if (hipFuncSetAttribute((const void*)mega_fwd, hipFuncAttributeMaxDynamicSharedMemorySize, LDS_BYTES) != hipSuccess) { fprintf(stderr, "kernel_launch: hipFuncSetAttribute failed\n"); grid = -1; return; }
        if (hipOccupancyMaxActiveBlocksPerMultiprocessor(&per_cu, (const void*)mega_fwd, 512, LDS_BYTES) != hipSuccess || per_cu < 1) { fprintf(stderr, "kernel_launch: occupancy query failed (%d)\n", per_cu); (void)hipGetLastError(); per_cu = 1; }
        grid = cus * 1;
        if (grid < 64) { fprintf(stderr, "kernel_launch: grid %d too small\n", grid); grid = -1; return; }
    }
    if (grid < 0) return;
    Params p{};
    for (int i = 0; i < 26; ++i) p.in[i] = (const float*)d_in[i];
    p.out = (float*)d_out; p.ws = (unsigned char*)d_ws;
#if MK_PER_PHASE
    for (int ph = 0; ph < NPH * DEPTH; ++ph) { p.ph_lo = ph; p.ph_hi = ph + 1; void* args[] = {&p};
        hipError_t e = hipLaunchCooperativeKernel((void*)mega_fwd, dim3(grid), dim3(512), args, LDS_BYTES, stream);
        if (e != hipSuccess) { fprintf(stderr, "launch %d failed: %s\n", ph, hipGetErrorString(e)); break; } }
#else
    p.ph_lo = 0; p.ph_hi = NPH * DEPTH; void* args[] = {&p};
    hipError_t e = hipLaunchCooperativeKernel((void*)mega_fwd, dim3(grid), dim3(512), args, LDS_BYTES, stream);
    if (e != hipSuccess) fprintf(stderr, "cooperative launch failed: %s (grid %d)\n", hipGetErrorString(e), grid);
#endif
}
```
